# Optimizing an MI355X kernel written in HIP

```python
import jax, jax.numpy as jnp
from jax import lax
import numpy as np

D_MODEL = 1024
BATCH = 8
SEQ = 2048
DEPTH = 1

ATTN_HEADS = 8
QK_NOPE_DIM = 64
QK_ROPE_DIM = 32
QK_HEAD_DIM = QK_NOPE_DIM + QK_ROPE_DIM
V_HEAD_DIM = 64
Q_LORA_RANK = D_MODEL // 4
KV_LORA_RANK = D_MODEL // 8
ROPE_THETA = 10000.0
Q_BLOCK = 128
ATTN_WIDTH = ATTN_HEADS * V_HEAD_DIM

SSM_HEADS = 8
SSM_HEAD_DIM = 64
SSM_INNER = SSM_HEADS * SSM_HEAD_DIM
SSM_GROUPS = 2
SSM_STATE = 128
SSM_CONV = 5
SSM_CHUNK = 128
SSM_CONV_CH = SSM_INNER + 2 * SSM_GROUPS * SSM_STATE

D_MIX = ATTN_WIDTH + SSM_INNER
D_FF = 4 * D_MODEL
EPS = 1e-6

IN_SPLITS = (Q_LORA_RANK, KV_LORA_RANK, QK_ROPE_DIM, SSM_INNER, SSM_CONV_CH, 2 * SSM_HEADS)
IN_WIDTH = Q_LORA_RANK + KV_LORA_RANK + QK_ROPE_DIM + SSM_INNER + SSM_CONV_CH + 2 * SSM_HEADS

kernel_name = 'hybrid_mla_mamba2_sqrelu_encoder'


def rms_norm(x, g):
    xf = x.astype(jnp.float32)
    y = xf * lax.rsqrt(jnp.mean(xf * xf, axis=-1, keepdims=True) + EPS)
    return (y * g.astype(jnp.float32)).astype(x.dtype)


def rope_cos_sin(positions, dtype):
    inv_freq = 1.0 / (ROPE_THETA ** (jnp.arange(0, QK_ROPE_DIM, 2, dtype=jnp.float32) / QK_ROPE_DIM))
    ang = positions.astype(jnp.float32)[..., None] * inv_freq
    ang = jnp.concatenate([ang, ang], axis=-1)[:, :, None, :]
    return jnp.cos(ang).astype(dtype), jnp.sin(ang).astype(dtype)


def apply_rope(x, cos, sin):
    x1, x2 = jnp.split(x, 2, axis=-1)
    return x * cos + jnp.concatenate([-x2, x1], axis=-1) * sin


def mla_attention(c_q, c_kv, k_pe, cos, sin, q_a_norm_g, w_uq, kv_a_norm_g, w_ukv, q_norm_g, k_norm_g):
    b, s, _ = c_q.shape
    q = (rms_norm(c_q, q_a_norm_g) @ w_uq).reshape(b, s, ATTN_HEADS, QK_HEAD_DIM)
    kv = (rms_norm(c_kv, kv_a_norm_g) @ w_ukv).reshape(b, s, ATTN_HEADS, QK_NOPE_DIM + V_HEAD_DIM)
    k_nope, v = jnp.split(kv, [QK_NOPE_DIM], axis=-1)
    k_pe_h = jnp.broadcast_to(k_pe[:, :, None, :], (b, s, ATTN_HEADS, QK_ROPE_DIM))
    k = jnp.concatenate([k_nope, k_pe_h], axis=-1)
    q = rms_norm(q, q_norm_g)
    k = rms_norm(k, k_norm_g)
    q = jnp.concatenate([q[..., :QK_NOPE_DIM], apply_rope(q[..., QK_NOPE_DIM:], cos, sin)], axis=-1)
    k = jnp.concatenate([k[..., :QK_NOPE_DIM], apply_rope(k[..., QK_NOPE_DIM:], cos, sin)], axis=-1)
    scale = QK_HEAD_DIM ** -0.5
    n_blk = s // Q_BLOCK
    q_blocks = jnp.moveaxis(q.reshape(b, n_blk, Q_BLOCK, ATTN_HEADS, QK_HEAD_DIM), 1, 0)

    def attend(qb):
        logits = jnp.einsum('bqhd,bkhd->bhqk', qb, k).astype(jnp.float32) * scale
        p = jax.nn.softmax(logits, axis=-1).astype(v.dtype)
        return jnp.einsum('bhqk,bkhd->bqhd', p, v)

    o = lax.map(attend, q_blocks)
    return jnp.moveaxis(o, 0, 1).reshape(b, s, ATTN_WIDTH)


def ssd_scan(x, dt, a, bmat, cmat):
    b, s, h, p = x.shape
    g, n = bmat.shape[-2], bmat.shape[-1]
    r = h // g
    c = s // SSM_CHUNK
    L = SSM_CHUNK
    xdt = (x * dt[..., None]).reshape(b, c, L, g, r, p)
    da = jnp.moveaxis((dt * a).reshape(b, c, L, g, r), 2, -1)
    a_cs = jnp.cumsum(da, axis=-1)
    bm = bmat.reshape(b, c, L, g, n)
    cm = cmat.reshape(b, c, L, g, n)
    seg = a_cs[..., :, None] - a_cs[..., None, :]
    lower = jnp.tril(jnp.ones((L, L), dtype=bool))
    decay_in = jnp.exp(jnp.where(lower, seg, -jnp.inf))
    cb = jnp.einsum('bclgn,bcsgn->bcgls', cm, bm)
    y_diag = jnp.einsum('bcgls,bcgrls,bcsgrp->bclgrp', cb, decay_in, xdt)
    decay_to_end = jnp.exp(a_cs[..., -1:] - a_cs)
    chunk_states = jnp.einsum('bclgn,bcgrl,bclgrp->bcgrpn', bm, decay_to_end, xdt)
    chunk_decay = jnp.exp(a_cs[..., -1])

    def step(state, inp):
        dec, new = inp
        return state * dec[..., None, None] + new, state

    init = jnp.zeros((b, g, r, p, n), dtype=chunk_states.dtype)
    _, prev = lax.scan(step, init, (jnp.moveaxis(chunk_decay, 1, 0), jnp.moveaxis(chunk_states, 1, 0)))
    prev = jnp.moveaxis(prev, 0, 1)
    y_off = jnp.einsum('bclgn,bcgrpn,bcgrl->bclgrp', cm, prev, jnp.exp(a_cs))
    return (y_diag + y_off).reshape(b, s, h, p)


def mamba2_mixer(z, xbc, dt_raw, conv_w, conv_b, a_log_fwd, a_log_bwd, dt_bias_fwd, dt_bias_bwd, d_skip, ssm_norm_g):
    b, s, _ = z.shape
    xbc = lax.conv_general_dilated(
        xbc, conv_w, window_strides=(1,), padding=[(SSM_CONV // 2, SSM_CONV // 2)],
        dimension_numbers=('NWC', 'WIO', 'NWC'), feature_group_count=SSM_CONV_CH) + conv_b
    xbc = jax.nn.silu(xbc)
    xs, bm, cm = jnp.split(xbc, [SSM_INNER, SSM_INNER + SSM_GROUPS * SSM_STATE], axis=-1)
    xs = xs.reshape(b, s, SSM_HEADS, SSM_HEAD_DIM)
    bm = bm.reshape(b, s, SSM_GROUPS, SSM_STATE)
    cm = cm.reshape(b, s, SSM_GROUPS, SSM_STATE)
    dt_f, dt_b = jnp.split(dt_raw, 2, axis=-1)
    dt_f = jax.nn.softplus(dt_f + dt_bias_fwd)
    dt_b = jax.nn.softplus(dt_b + dt_bias_bwd)
    y_f = ssd_scan(xs, dt_f, -jnp.exp(a_log_fwd), bm, cm)
    flip = lambda t: jnp.flip(t, axis=1)
    y_b = flip(ssd_scan(flip(xs), flip(dt_b), -jnp.exp(a_log_bwd), flip(bm), flip(cm)))
    y = y_f + y_b + d_skip[:, None] * xs
    y = y.reshape(b, s, SSM_INNER) * jax.nn.silu(z)
    y = rms_norm(y.reshape(b, s, SSM_GROUPS, SSM_INNER // SSM_GROUPS),
                 ssm_norm_g.reshape(SSM_GROUPS, SSM_INNER // SSM_GROUPS))
    return y.reshape(b, s, SSM_INNER)


def hybrid_layer(x, cos, sin, ln_mix_g, w_in, q_a_norm_g, w_uq, kv_a_norm_g, w_ukv, q_norm_g, k_norm_g,
                 attn_out_norm_g, conv_w, conv_b, a_log_fwd, a_log_bwd, dt_bias_fwd, dt_bias_bwd, d_skip,
                 ssm_norm_g, w_out, ln_mlp_g, w_mlp_up, w_mlp_down):
    h = rms_norm(x, ln_mix_g)
    proj = h @ w_in
    split_idx = np.cumsum(IN_SPLITS)[:-1].tolist()
    c_q, c_kv, k_pe, z, xbc, dt_raw = jnp.split(proj, split_idx, axis=-1)
    attn = mla_attention(c_q, c_kv, k_pe, cos, sin, q_a_norm_g, w_uq, kv_a_norm_g, w_ukv, q_norm_g, k_norm_g)
    attn = rms_norm(attn, attn_out_norm_g)
    ssm = mamba2_mixer(z, xbc, dt_raw, conv_w, conv_b, a_log_fwd, a_log_bwd, dt_bias_fwd, dt_bias_bwd,
                       d_skip, ssm_norm_g)
    x = x + jnp.concatenate([attn, ssm], axis=-1) @ w_out
    hm = rms_norm(x, ln_mlp_g)
    x = x + jnp.square(jax.nn.relu(hm @ w_mlp_up)) @ w_mlp_down
    return x


def setup_inputs(seed: int = 0) -> dict:
    key = jax.random.key(seed)
    ks = jax.random.split(key, 24)
    f32 = jnp.float32

    def nrm(k, shape, fan_in):
        return jax.random.normal(k, shape, f32) * (fan_in ** -0.5)

    def gain(k, shape):
        return 1.0 + 0.02 * jax.random.normal(k, shape, f32)

    x = jax.random.normal(ks[0], (BATCH, SEQ, D_MODEL), f32)
    positions = (jnp.arange(SEQ, dtype=jnp.int32)[None, :]
                 + jax.random.randint(ks[1], (BATCH, 1), 0, 4096, dtype=jnp.int32))
    a_log_fwd = jnp.log(jax.random.uniform(ks[13], (DEPTH, SSM_HEADS), f32, 1.0, 16.0))
    a_log_bwd = jnp.log(jax.random.uniform(ks[14], (DEPTH, SSM_HEADS), f32, 1.0, 16.0))

    def dt_bias(k):
        dt = jnp.exp(jax.random.uniform(k, (DEPTH, SSM_HEADS), f32, np.log(1e-3), np.log(1e-1)))
        return dt + jnp.log(-jnp.expm1(-dt))

    return {
        'x': x,
        'positions': positions,
        'ln_mix_g': gain(ks[2], (DEPTH, D_MODEL)),
        'w_in': nrm(ks[3], (DEPTH, D_MODEL, IN_WIDTH), D_MODEL),
        'q_a_norm_g': gain(ks[4], (DEPTH, Q_LORA_RANK)),
        'w_uq': nrm(ks[5], (DEPTH, Q_LORA_RANK, ATTN_HEADS * QK_HEAD_DIM), Q_LORA_RANK),
        'kv_a_norm_g': gain(ks[6], (DEPTH, KV_LORA_RANK)),
        'w_ukv': nrm(ks[7], (DEPTH, KV_LORA_RANK, ATTN_HEADS * (QK_NOPE_DIM + V_HEAD_DIM)), KV_LORA_RANK),
        'q_norm_g': gain(ks[8], (DEPTH, QK_HEAD_DIM)),
        'k_norm_g': gain(ks[9], (DEPTH, QK_HEAD_DIM)),
        'attn_out_norm_g': gain(ks[10], (DEPTH, ATTN_WIDTH)),
        'conv_w': nrm(ks[11], (DEPTH, SSM_CONV, 1, SSM_CONV_CH), SSM_CONV),
        'conv_b': 0.02 * jax.random.normal(ks[12], (DEPTH, SSM_CONV_CH), f32),
        'a_log_fwd': a_log_fwd,
        'a_log_bwd': a_log_bwd,
        'dt_bias_fwd': dt_bias(ks[15]),
        'dt_bias_bwd': dt_bias(ks[16]),
        'd_skip': gain(ks[17], (DEPTH, SSM_HEADS)),
        'ssm_norm_g': gain(ks[18], (DEPTH, SSM_INNER)),
        'w_out': nrm(ks[19], (DEPTH, D_MIX, D_MODEL), D_MIX),
        'ln_mlp_g': gain(ks[20], (DEPTH, D_MODEL)),
        'w_mlp_up': nrm(ks[21], (DEPTH, D_MODEL, D_FF), D_MODEL),
        'w_mlp_down': nrm(ks[22], (DEPTH, D_FF, D_MODEL), D_FF),
    }


def reference(x, positions, ln_mix_g, w_in, q_a_norm_g, w_uq, kv_a_norm_g, w_ukv, q_norm_g, k_norm_g,
              attn_out_norm_g, conv_w, conv_b, a_log_fwd, a_log_bwd, dt_bias_fwd, dt_bias_bwd, d_skip,
              ssm_norm_g, w_out, ln_mlp_g, w_mlp_up, w_mlp_down):
    cos, sin = rope_cos_sin(positions, x.dtype)
    for l in range(DEPTH):
        x = hybrid_layer(x, cos, sin, ln_mix_g[l], w_in[l], q_a_norm_g[l], w_uq[l], kv_a_norm_g[l], w_ukv[l],
                         q_norm_g[l], k_norm_g[l], attn_out_norm_g[l], conv_w[l], conv_b[l], a_log_fwd[l],
                         a_log_bwd[l], dt_bias_fwd[l], dt_bias_bwd[l], d_skip[l], ssm_norm_g[l], w_out[l],
                         ln_mlp_g[l], w_mlp_up[l], w_mlp_down[l])
    return x
```

```cpp
#include <hip/hip_runtime.h>
#include <hip/hip_cooperative_groups.h>
#include <cstdio>
#include <cstdint>
namespace cg = cooperative_groups;
__device__ __forceinline__ int opaque_tid() { int t = threadIdx.x; asm volatile("" : "+v"(t)); return t; }

namespace pg8 {
#define PG8_LAS __attribute__((address_space(3)))
typedef unsigned short bf16_t;
typedef short bf16x8 __attribute__((ext_vector_type(8)));
typedef float f32x4 __attribute__((ext_vector_type(4)));
typedef unsigned u32x4 __attribute__((ext_vector_type(4)));
constexpr int BM = 256, BK = 64, HALF = 128, HTB = HALF * BK * 2  , STAGE_BYTES = 8 * HTB, NXCD = 8, WGM = 8;

__host__ __device__ __forceinline__ int lds_byte(int r, int c) { const int st = (r >> 4) * 2 + (c >> 5), rr = r & 15, cc = c & 31, ob = rr * 64 + cc * 2; return st * 1024 + (ob ^ (((ob >> 9) & 1) << 5)); }
__host__ __device__ __forceinline__ void stage_rc(int b, int& R, int& C) { const int st = b / 1024, sb = b % 1024, swz = sb ^ (((sb >> 9) & 1) << 5); R = (st >> 1) * 16 + swz / 64; C = (st & 1) * 32 + (swz % 64) / 2; }
__host__ __device__ __forceinline__ int perm32(int rho) { const int n = rho >> 4, i = rho & 15; return 8 * (i >> 2) + 4 * n + (i & 3); }

struct Unit { int pm, pn; };
struct Gemm { const bf16_t* A; const bf16_t* Bt; int M, N, K, lda; };

struct StaticOrder {
    int nM, nN, nwg, G, c;
    __host__ __device__ void init(int M, int N, int G_, int c_) { nM = M / BM; nN = N / BM; nwg = nM * nN; G = G_; c = c_; }
    __host__ __device__ bool next(int i, Unit& u) const {
        const long L = (long)i * G + c; if (L >= nwg) return false;
        int wgid = (int)L; { const int q = nwg / NXCD, r = nwg % NXCD, xcd = wgid % NXCD, off = wgid / NXCD; wgid = (xcd < r ? xcd * (q + 1) : r * (q + 1) + (xcd - r) * q) + off; }
        const int nig = WGM * nN, gid = wgid / nig, fm = gid * WGM, gsz = (nM - fm) < WGM ? (nM - fm) : WGM;
        u.pm = fm + ((wgid % nig) % gsz); u.pn = (wgid % nig) / gsz; return true;
    }
    __device__ __forceinline__ void a_ready(const Unit&) const {}
    __device__ __forceinline__ void done(const Unit&) const {}
};

__device__ __forceinline__ unsigned cvt_pk_bf16(float lo, float hi) { unsigned r; asm volatile("v_cvt_pk_bf16_f32 %0, %1, %2" : "=v"(r) : "v"(lo), "v"(hi)); return r; }
typedef float f32x2 __attribute__((ext_vector_type(2)));

template <int MODE> struct EpiBf16 {
    static constexpr bool PERM = true, AFTER_DRAIN = false, KHOOK = false;
    bf16_t* O; int ldc; float* side;
    __device__ __forceinline__ void operator()(const f32x4 (&acc)[2][2][4][2], const Unit& u, int wr, int wc, int fr, int fq) const {
        const int row0 = u.pm * BM + wr * 64 + fr; const int col0 = u.pn * BM + wc * 32 + 8 * fq;
        float rsv[2][4];
#pragma unroll
        for (int ai = 0; ai < 2; ++ai)
#pragma unroll
            for (int m = 0; m < 4; ++m) rsv[ai][m] = (MODE == 1) ? side[row0 + ai * HALF + m * 16] : 0.f;
#pragma unroll
        for (int ai = 0; ai < 2; ++ai)
#pragma unroll
            for (int m = 0; m < 4; ++m) { const int row = row0 + ai * HALF + m * 16; bf16_t* rowp = O + (size_t)row * ldc + col0;
                float rs = 1.f; if (MODE == 1) rs = 1.0f / sqrtf(rsv[ai][m] * (1.0f / 1024.0f) + 1e-6f);
#pragma unroll
                for (int bj = 0; bj < 2; ++bj) { f32x4 v0 = acc[ai][bj][m][0], v1 = acc[ai][bj][m][1];
                    if (MODE == 1) {
#pragma unroll
                        for (int e = 0; e < 4; ++e) { float a = v0[e] > 0.f ? v0[e] * rs : 0.f; v0[e] = a * a; float b = v1[e] > 0.f ? v1[e] * rs : 0.f; v1[e] = b * b; } }
                    if (MODE == 2) { if (u.pn == 7 && bj == 1 && wc == 1 && fq < 2) { float* sp = side + (size_t)row * 16 + 8 * fq; *(f32x4*)sp = v0; *(f32x4*)(sp + 4) = v1; } }
                    u32x4 w; w.x = cvt_pk_bf16(v0[0], v0[1]); w.y = cvt_pk_bf16(v0[2], v0[3]); w.z = cvt_pk_bf16(v1[0], v1[1]); w.w = cvt_pk_bf16(v1[2], v1[3]);
                    *(u32x4*)(rowp + bj * HALF) = w; } }
    }
};
template <bool STATS> struct EpiResid {
    static constexpr bool PERM = true, AFTER_DRAIN = false, KHOOK = false;
    const float* base; float* out; int ldc; bf16_t* xb; float* ssq;
    __device__ __forceinline__ void operator()(const f32x4 (&acc)[2][2][4][2], const Unit& u, int wr, int wc, int fr, int fq) const {
        const int row0 = u.pm * BM + wr * 64 + fr; const int col0 = u.pn * BM + wc * 32 + 8 * fq;
#pragma unroll
        for (int ai = 0; ai < 2; ++ai) {
            f32x4 b0[4][2], b1[4][2]; u32x4 wx[4][2];
#pragma unroll
            for (int m = 0; m < 4; ++m)
#pragma unroll
                for (int bj = 0; bj < 2; ++bj) { const size_t o = (size_t)(row0 + ai * HALF + m * 16) * ldc + col0 + bj * HALF;
                    if (STATS) { b0[m][bj] = *(const f32x4*)(base + o); b1[m][bj] = *(const f32x4*)(base + o + 4); } else wx[m][bj] = *(const u32x4*)(xb + o); }
#pragma unroll
            for (int m = 0; m < 4; ++m) { const int row = row0 + ai * HALF + m * 16; const size_t ro = (size_t)row * ldc + col0; float sq = 0.f;
#pragma unroll
                for (int bj = 0; bj < 2; ++bj) { const size_t o = ro + bj * HALF;
                    if (STATS) {
                        const f32x4 v0 = b0[m][bj] + acc[ai][bj][m][0], v1 = b1[m][bj] + acc[ai][bj][m][1];
                        u32x4 w; w.x = cvt_pk_bf16(v0[0], v0[1]); w.y = cvt_pk_bf16(v0[2], v0[3]); w.z = cvt_pk_bf16(v1[0], v1[1]); w.w = cvt_pk_bf16(v1[2], v1[3]); *(u32x4*)(xb + o) = w;
                        sq += (v0[0] * v0[0] + v0[1] * v0[1]) + (v0[2] * v0[2] + v0[3] * v0[3]) + (v1[0] * v1[0] + v1[1] * v1[1]) + (v1[2] * v1[2] + v1[3] * v1[3]);
                    } else {
                        const u32x4 w = wx[m][bj];
                        f32x4 c0, c1; c0[0] = __builtin_bit_cast(float, w.x << 16); c0[1] = __builtin_bit_cast(float, w.x & 0xffff0000u); c0[2] = __builtin_bit_cast(float, w.y << 16); c0[3] = __builtin_bit_cast(float, w.y & 0xffff0000u);
                        c1[0] = __builtin_bit_cast(float, w.z << 16); c1[1] = __builtin_bit_cast(float, w.z & 0xffff0000u); c1[2] = __builtin_bit_cast(float, w.w << 16); c1[3] = __builtin_bit_cast(float, w.w & 0xffff0000u);
                        *(f32x4*)(out + o) = c0 + acc[ai][bj][m][0]; *(f32x4*)(out + o + 4) = c1 + acc[ai][bj][m][1];
                    } }
                if (STATS) { sq += __shfl_xor(sq, 16); sq += __shfl_xor(sq, 32); if (fq == 0) atomicAdd(ssq + row, sq); } }
        }
    }
};

struct EpiResidMix {
    static constexpr bool PERM = true, AFTER_DRAIN = false, KHOOK = true;
    const float* base; int ldc; bf16_t* xb; float* ssq;
    const PG8_LAS float* fac;
    __device__ __forceinline__ int slot_of(const Unit& u) const { const PG8_LAS int* pms = (const PG8_LAS int*)(fac + 4 * 768); int sl = 0;
#pragma unroll
        for (int i = 1; i < 4; ++i) if (pms[i] == u.pm) sl = i;
        return sl; }
    __device__ __forceinline__ void khook(f32x4 (&acc)[2][2][4][2], const Unit& u, int t, int wr, int fr) const {
        const PG8_LAS float* f = fac + slot_of(u) * 768 + (t == 8 ? 0 : 256) + wr * 64 + fr;
#pragma unroll
        for (int ai = 0; ai < 2; ++ai)
#pragma unroll
            for (int m = 0; m < 4; ++m) { const float sc = f[ai * HALF + m * 16];
#pragma unroll
                for (int bj = 0; bj < 2; ++bj)
#pragma unroll
                    for (int n = 0; n < 2; ++n) acc[ai][bj][m][n] = acc[ai][bj][m][n] * sc; }
    }
    __device__ __forceinline__ void operator()(const f32x4 (&acc)[2][2][4][2], const Unit& u, int wr, int wc, int fr, int fq) const {
        const int row0 = u.pm * BM + wr * 64 + fr; const int col0 = u.pn * BM + wc * 32 + 8 * fq;
        const PG8_LAS float* f = fac + slot_of(u) * 768 + 512 + wr * 64 + fr;
#pragma unroll
        for (int ai = 0; ai < 2; ++ai) {
            f32x4 b0[4][2], b1[4][2]; float fs[4];
#pragma unroll
            for (int m = 0; m < 4; ++m) { fs[m] = f[ai * HALF + m * 16];
#pragma unroll
                for (int bj = 0; bj < 2; ++bj) { const size_t o = (size_t)(row0 + ai * HALF + m * 16) * ldc + col0 + bj * HALF; b0[m][bj] = *(const f32x4*)(base + o); b1[m][bj] = *(const f32x4*)(base + o + 4); } }
#pragma unroll
            for (int m = 0; m < 4; ++m) { const int row = row0 + ai * HALF + m * 16; const size_t ro = (size_t)row * ldc + col0; float sq = 0.f;
#pragma unroll
                for (int bj = 0; bj < 2; ++bj) { const size_t o = ro + bj * HALF;
                    const f32x4 v0 = b0[m][bj] + acc[ai][bj][m][0] * fs[m], v1 = b1[m][bj] + acc[ai][bj][m][1] * fs[m];
                    u32x4 w; w.x = cvt_pk_bf16(v0[0], v0[1]); w.y = cvt_pk_bf16(v0[2], v0[3]); w.z = cvt_pk_bf16(v1[0], v1[1]); w.w = cvt_pk_bf16(v1[2], v1[3]); *(u32x4*)(xb + o) = w;
                    sq += (v0[0] * v0[0] + v0[1] * v0[1]) + (v0[2] * v0[2] + v0[3] * v0[3]) + (v1[0] * v1[0] + v1[1] * v1[1]) + (v1[2] * v1[2] + v1[3] * v1[3]); }
                sq += __shfl_xor(sq, 16); sq += __shfl_xor(sq, 32); if (fq == 0) atomicAdd(ssq + row, sq); }
        }
    }
};

template <class Epi, class Sched, bool ALIGN_EPI = false, bool SP2 = false>
__device__ __forceinline__ void gemm_phase(PG8_LAS unsigned char* lds, const Gemm g, const Sched& S, const Epi& E) {
    const int tid = opaque_tid(), wid = __builtin_amdgcn_readfirstlane(tid >> 6), lane = tid & 63, wr = wid >> 2, wc = wid & 3, fr = lane & 15, fq = lane >> 4;
    int K = g.K; asm volatile("" : "+s"(K));
    const int nt = K / BK;
    unsigned voffA[2], voffB[2];
#pragma unroll
    for (int i = 0; i < 2; ++i) { int R, C; stage_rc(tid * 16 + i * 8192, R, C); const int Rb = Epi::PERM ? ((R & ~31) + perm32(R & 31)) : R;
        voffA[i] = (unsigned)(R * g.lda + C) * 2u; voffB[i] = (unsigned)(Rb * K + C) * 2u; }
    const size_t kstep = (size_t)(BK * 2);
    const size_t hstepB = (size_t)HALF * K * 2, hstepA = (size_t)HALF * g.lda * 2;
    const size_t tstepB = 2 * hstepB, tstepA = 2 * hstepA;
    const unsigned ldsw = (unsigned)wid * 1024u;
    const int aoff = lds_byte(wr * 64 + fr, fq * 8), boff = lds_byte(wc * 32 + fr, fq * 8);
#define PG8_SA(b, h) (((b) * 2 + (h)) * HTB)
#define PG8_SB(b, h) ((4 + (b) * 2 + (h)) * HTB)
#define PG8_STAGE(bufoff, gbase, voff) do { _Pragma("unroll") for (int _i = 0; _i < 2; ++_i) \
        __builtin_amdgcn_global_load_lds((const unsigned*)((const char*)(gbase) + (voff)[_i]), (PG8_LAS unsigned*)(lds + (bufoff) + ldsw + _i * 8192), 16, 0, 0); } while (0)
#define PG8_LDA(dst, b, h) do { _Pragma("unroll") for (int m = 0; m < 4; ++m) _Pragma("unroll") for (int k = 0; k < 2; ++k) dst[m][k] = *(const PG8_LAS bf16x8*)(lds + PG8_SA(b, h) + aoff + m * 2048 + k * 1024); } while (0)
#define PG8_LDB(dst, b, h) do { _Pragma("unroll") for (int n = 0; n < 2; ++n) _Pragma("unroll") for (int k = 0; k < 2; ++k) dst[n][k] = *(const PG8_LAS bf16x8*)(lds + PG8_SB(b, h) + boff + n * 2048 + k * 1024); } while (0)
#define PG8_MMA(ai, bj, At, Bt) do { __builtin_amdgcn_s_setprio(1); _Pragma("unroll") for (int m = 0; m < 4; ++m) _Pragma("unroll") for (int n = 0; n < 2; ++n) _Pragma("unroll") for (int k = 0; k < 2; ++k) \
        acc[ai][bj][m][n] = __builtin_amdgcn_mfma_f32_16x16x32_bf16(Bt[n][k], At[m][k], acc[ai][bj][m][n], 0, 0, 0); __builtin_amdgcn_s_setprio(0); } while (0)
#define PG8_WAIT_V(n) asm volatile("s_waitcnt vmcnt(" #n ")" ::: "memory")
#define PG8_WAIT_L(n) asm volatile("s_waitcnt lgkmcnt(" #n ")" ::: "memory")
#define PG8_BAR __builtin_amdgcn_s_barrier()
#define PG8_SCHED __builtin_amdgcn_sched_barrier(0)
    Unit cur, nxt; int ui = 0;
    if (!S.next(0, cur)) return;
    f32x4 acc[2][2][4][2];
#pragma unroll
    for (int a = 0; a < 2; ++a)
#pragma unroll
        for (int b = 0; b < 2; ++b)
#pragma unroll
            for (int m = 0; m < 4; ++m)
#pragma unroll
                for (int n = 0; n < 2; ++n) acc[a][b][m][n] = (f32x4){0.f, 0.f, 0.f, 0.f};
    bf16x8 At[4][2], B0[2][2], B1[2][2];
    const char* cA = (const char*)g.A + (size_t)cur.pm * tstepA; const char* cB = (const char*)g.Bt + (size_t)cur.pn * tstepB;
    S.a_ready(cur);
    if constexpr (SP2) {
        PG8_STAGE(PG8_SB(0, 0), cB, voffB); PG8_STAGE(PG8_SB(0, 1), cB + hstepB, voffB); PG8_STAGE(PG8_SA(0, 0), cA, voffA); PG8_STAGE(PG8_SA(0, 1), cA + hstepA, voffA);
        if (wr == 1) PG8_BAR;
        PG8_WAIT_V(2); PG8_BAR;
        PG8_STAGE(PG8_SB(1, 0), cB + kstep, voffB); PG8_STAGE(PG8_SA(1, 0), cA + kstep, voffA); PG8_STAGE(PG8_SB(1, 1), cB + hstepB + kstep, voffB);
        PG8_WAIT_V(6); PG8_BAR;
    } else {
        PG8_STAGE(PG8_SB(0, 0), cB, voffB); PG8_STAGE(PG8_SA(0, 0), cA, voffA); PG8_STAGE(PG8_SB(0, 1), cB + hstepB, voffB); PG8_STAGE(PG8_SA(0, 1), cA + hstepA, voffA);
        if (wr == 1) PG8_BAR;
        PG8_WAIT_V(4); PG8_BAR;
        PG8_STAGE(PG8_SB(1, 0), cB + kstep, voffB); PG8_STAGE(PG8_SA(1, 0), cA + kstep, voffA); PG8_STAGE(PG8_SB(1, 1), cB + hstepB + kstep, voffB);
        PG8_WAIT_V(6); PG8_BAR;
    }
    for (;;) {
        const bool has_next = S.next(ui + 1, nxt);
        const char* nA = has_next ? (const char*)g.A + (size_t)nxt.pm * tstepA : cA; const char* nB = has_next ? (const char*)g.Bt + (size_t)nxt.pn * tstepB : cB;
        for (int t = 0; t < nt; t += 2) {
            if constexpr (Epi::KHOOK) { if (t == 8 || t == 12) E.khook(acc, cur, t, wr, fr); }
            const bool last = (t == nt - 2);
            const char* a1 = cA + (size_t)(t + 1) * kstep;
            const char* a2 = last ? nA : cA + (size_t)(t + 2) * kstep; const char* b2 = last ? nB : cB + (size_t)(t + 2) * kstep;
            const char* a3 = a2 + kstep; const char* b3 = b2 + kstep;
            if (last && has_next) S.a_ready(nxt);
            if constexpr (SP2) {
            PG8_LDB(B0, 0, 0); PG8_LDB(B1, 0, 1); PG8_SCHED; PG8_LDA(At, 0, 0); PG8_STAGE(PG8_SA(1, 1), a1 + hstepA, voffA);
            PG8_WAIT_V(8); PG8_WAIT_L(0); PG8_BAR; PG8_MMA(0, 0, At, B0); PG8_MMA(0, 1, At, B1); PG8_BAR; PG8_SCHED;
            PG8_LDA(At, 0, 1); PG8_STAGE(PG8_SB(0, 0), b2, voffB); PG8_STAGE(PG8_SB(0, 1), b2 + hstepB, voffB); PG8_STAGE(PG8_SA(0, 0), a2, voffA);
            PG8_WAIT_V(8); PG8_WAIT_L(0); PG8_BAR; PG8_MMA(1, 0, At, B0); PG8_MMA(1, 1, At, B1); PG8_BAR; PG8_SCHED;
            PG8_LDB(B0, 1, 0); PG8_LDB(B1, 1, 1); PG8_SCHED; PG8_LDA(At, 1, 0); PG8_STAGE(PG8_SA(0, 1), a2 + hstepA, voffA);
            PG8_WAIT_V(8); PG8_WAIT_L(0); PG8_BAR; PG8_MMA(0, 0, At, B0); PG8_MMA(0, 1, At, B1); PG8_BAR; PG8_SCHED;
            PG8_LDA(At, 1, 1); PG8_STAGE(PG8_SB(1, 0), b3, voffB); PG8_STAGE(PG8_SB(1, 1), b3 + hstepB, voffB); PG8_STAGE(PG8_SA(1, 0), a3, voffA);
            PG8_WAIT_V(8); PG8_WAIT_L(0); PG8_BAR; PG8_MMA(1, 0, At, B0); PG8_MMA(1, 1, At, B1); PG8_BAR; PG8_SCHED;
            } else {
            PG8_LDB(B0, 0, 0); PG8_SCHED; PG8_LDA(At, 0, 0); PG8_STAGE(PG8_SA(1, 1), a1 + hstepA, voffA);
            PG8_WAIT_L(8); PG8_BAR; PG8_WAIT_L(0); PG8_MMA(0, 0, At, B0); PG8_BAR; PG8_SCHED;
            PG8_LDB(B1, 0, 1); PG8_STAGE(PG8_SB(0, 0), b2, voffB);
            PG8_BAR; PG8_WAIT_L(0); PG8_MMA(0, 1, At, B1); PG8_BAR;
            PG8_LDA(At, 0, 1); PG8_STAGE(PG8_SA(0, 0), a2, voffA);
            PG8_BAR; PG8_WAIT_L(0); PG8_MMA(1, 0, At, B0); PG8_BAR; PG8_SCHED;
            PG8_STAGE(PG8_SB(0, 1), b2 + hstepB, voffB);
            PG8_WAIT_V(6); PG8_BAR; PG8_MMA(1, 1, At, B1); PG8_BAR;
            PG8_LDB(B0, 1, 0); PG8_SCHED; PG8_LDA(At, 1, 0); PG8_STAGE(PG8_SA(0, 1), a2 + hstepA, voffA);
            PG8_WAIT_L(8); PG8_BAR; PG8_WAIT_L(0); PG8_MMA(0, 0, At, B0); PG8_BAR; PG8_SCHED;
            PG8_LDB(B1, 1, 1); PG8_STAGE(PG8_SB(1, 0), b3, voffB);
            PG8_BAR; PG8_WAIT_L(0); PG8_MMA(0, 1, At, B1); PG8_BAR;
            PG8_LDA(At, 1, 1); PG8_STAGE(PG8_SA(1, 0), a3, voffA);
            PG8_BAR; PG8_WAIT_L(0); PG8_MMA(1, 0, At, B0); PG8_BAR; PG8_SCHED;
            PG8_STAGE(PG8_SB(1, 1), b3 + hstepB, voffB);
            PG8_WAIT_V(6); PG8_BAR; PG8_MMA(1, 1, At, B1); PG8_BAR;
            }
        }
        if constexpr (ALIGN_EPI) { if (wr == 0) PG8_BAR; }
        if constexpr (!Epi::AFTER_DRAIN) { E(acc, cur, wr, wc, fr, fq); S.done(cur); }
        if (!has_next) break;
#pragma unroll
        for (int a = 0; a < 2; ++a)
#pragma unroll
            for (int b = 0; b < 2; ++b)
#pragma unroll
                for (int m = 0; m < 4; ++m)
#pragma unroll
                    for (int n = 0; n < 2; ++n) acc[a][b][m][n] = (f32x4){0.f, 0.f, 0.f, 0.f};
        cur = nxt; cA = nA; cB = nB; ++ui;
        if constexpr (ALIGN_EPI) { if (wr == 1) PG8_BAR; }
    }
    PG8_WAIT_V(0);
    if constexpr (!ALIGN_EPI) { if (wr == 0) PG8_BAR; }
    PG8_BAR;
    if constexpr (Epi::AFTER_DRAIN) { E.fused(acc, cur, wr, wc, fr, fq, lds, wid, lane); S.done(cur); }
#undef PG8_SA
#undef PG8_SB
#undef PG8_STAGE
#undef PG8_LDA
#undef PG8_LDB
#undef PG8_MMA
#undef PG8_WAIT_V
#undef PG8_WAIT_L
#undef PG8_BAR
#undef PG8_SCHED
}
}
#define LAS __attribute__((address_space(3)))
typedef unsigned short bf16;
typedef float f32x4 __attribute__((ext_vector_type(4)));
typedef float f32x2 __attribute__((ext_vector_type(2)));
typedef float f32x16 __attribute__((ext_vector_type(16)));
typedef short bf16x8 __attribute__((ext_vector_type(8)));
typedef short s16x4 __attribute__((ext_vector_type(4)));
typedef unsigned u32x4 __attribute__((ext_vector_type(4)));
typedef unsigned u32x2 __attribute__((ext_vector_type(2)));
typedef __bf16 bf16x2_t __attribute__((ext_vector_type(2)));
#define MFMA32(a, b, c) __builtin_amdgcn_mfma_f32_32x32x16_bf16((a), (b), (c), 0, 0, 0)

constexpr int NB = 8, S_ = 2048, T_ = NB * S_, D_ = 1024, NPROJ = 2048, INW = 1968, FF = 4096;
constexpr int NWAVES = 8, NTHREADS = 512;
constexpr int LDS_BYTES = 144 * 1024;
constexpr float EPS = 1e-6f;
constexpr float LOG2E = 1.4426950408889634f;
constexpr int C_CQ = 0, C_CKV = 256, C_KPE = 384, C_Z = 416, C_XBC = 928, C_DT = 1952;
constexpr size_t MB = 1024 * 1024;
constexpr size_t WS_PROJ = 0, WS_QRAW = 64 * MB, WS_KVRAW = 88 * MB, WS_VEC = 120 * MB, WS_DTRAW = 124 * MB;
constexpr size_t WS_ATTNO = 64 * MB, WS_YG = 88 * MB, WS_U = 0;
constexpr size_t WS_HB = 128 * MB;
constexpr size_t WS_BT = WS_HB + 24 * MB;
constexpr size_t HST_OFF = (size_t)8 * 1024 * 1024;
constexpr size_t WS_K = 160 * MB, WS_VT = 184 * MB, WS_BM = 200 * MB, WS_CM = 208 * MB, WS_XT = 216 * MB;
constexpr size_t WS_WIN = 232 * MB, WS_WUQ = 236 * MB, WS_WUKV = WS_WUQ + 768 * 256 * 2, WS_WOUT = WS_WUKV + 1024 * 128 * 2, WS_WUP = WS_WOUT + 2 * MB, WS_WDN = WS_WUP + 8 * MB;
constexpr size_t WS_MIXRAW = 64 * MB;
constexpr size_t WS_SSQA = 255 * MB + 64 * 1024, WS_SSQY = 255 * MB + 128 * 1024;
constexpr size_t WS_BAR = 255 * MB + 256 * 1024;
constexpr int MISC_OFF = 140 * 1024;
constexpr size_t WS_SSQ = 255 * MB, WS_X1B = WS_K;
static_assert(WS_WDN + 8 * MB <= WS_SSQ, "ws map");

struct Args {
    const float* x; const int* pos; const float* ln_mix_g; const float* w_in; const float* q_a_g; const float* w_uq; const float* kv_a_g; const float* w_ukv;
    const float* q_norm_g; const float* k_norm_g; const float* attn_out_g; const float* conv_w; const float* conv_b; const float* a_log_f; const float* a_log_b;
    const float* dt_bias_f; const float* dt_bias_b; const float* d_skip; const float* ssm_norm_g; const float* w_out; const float* ln_mlp_g; const float* w_up; const float* w_dn;
    float* out; unsigned char* ws;
};

__device__ __forceinline__ unsigned f2bf(float f) { unsigned u = __builtin_bit_cast(unsigned, f); return (u + 0x7fffu + ((u >> 16) & 1u)) >> 16; }
__device__ __forceinline__ unsigned pk2(float lo, float hi) { f32x2 v = {lo, hi}; bf16x2_t b = __builtin_convertvector(v, bf16x2_t); return __builtin_bit_cast(unsigned, b); }
__device__ __forceinline__ float bf2f(unsigned short b) { return __builtin_bit_cast(float, (unsigned)b << 16); }
__device__ __forceinline__ float bflo(unsigned w) { return __builtin_bit_cast(float, w << 16); }
__device__ __forceinline__ float bfhi(unsigned w) { return __builtin_bit_cast(float, w & 0xffff0000u); }
__device__ __forceinline__ float wave_sum(float v) {
#pragma unroll
    for (int o = 1; o < 64; o <<= 1) v += __shfl_xor(v, o);
    return v;
}
__device__ __forceinline__ float ex2(float x) { return __builtin_amdgcn_exp2f(x); }
__device__ __forceinline__ float silu(float z) { return z / (1.f + __expf(-z)); }

__device__ __forceinline__ void transpose_item(const float* W, int K, int N, bf16* WT, const float* gain, LAS float* scr, int item, int nblk, int lane) {
    const int kb = item / nblk, nb = item % nblk, k0 = 64 * kb, n0 = 64 * nb;
    const int kr = lane >> 4, nc = 4 * (lane & 15);
    const bool ok = (n0 + nc) < N;
    f32x4 v[16];
#pragma unroll
    for (int i = 0; i < 16; ++i) { v[i] = (f32x4){0.f, 0.f, 0.f, 0.f}; if (ok) v[i] = *(const f32x4*)(W + (size_t)(k0 + 4 * i + kr) * N + n0 + nc); }
    if (gain) {
#pragma unroll
        for (int i = 0; i < 16; ++i) v[i] = v[i] * gain[k0 + 4 * i + kr]; }
#pragma unroll
    for (int i = 0; i < 16; ++i) { LAS float* d = scr + (4 * i + kr) * 65 + nc; d[0] = v[i].x; d[1] = v[i].y; d[2] = v[i].z; d[3] = v[i].w; }
    asm volatile("s_waitcnt lgkmcnt(0)" ::: "memory");
    const int c = lane & 7;
#pragma unroll
    for (int j = 0; j < 8; ++j) { const int n = (lane >> 3) + 8 * j; const LAS float* sp = scr + (8 * c) * 65 + n;
        u32x4 o; o.x = pk2(sp[0 * 65], sp[1 * 65]); o.y = pk2(sp[2 * 65], sp[3 * 65]); o.z = pk2(sp[4 * 65], sp[5 * 65]); o.w = pk2(sp[6 * 65], sp[7 * 65]);
        *(u32x4*)(WT + (size_t)(n0 + n) * K + k0 + 8 * c) = o; }
    asm volatile("s_waitcnt lgkmcnt(0)" ::: "memory");
}
__device__ __forceinline__ void rms_row_to_bf16(const float* xrow, const float* g, bf16* orow, int lane) {
    const f32x4* xr = (const f32x4*)xrow + lane; const f32x4* gr = (const f32x4*)g + lane;
    f32x4 v[4]; float s = 0.f;
#pragma unroll
    for (int j = 0; j < 4; ++j) { v[j] = xr[64 * j]; s += (v[j].x * v[j].x + v[j].y * v[j].y) + (v[j].z * v[j].z + v[j].w * v[j].w); }
    const float rstd = 1.f / sqrtf(wave_sum(s) * (1.f / D_) + EPS);
    u32x2* o8 = (u32x2*)orow + lane;
#pragma unroll
    for (int j = 0; j < 4; ++j) { const f32x4 gg = gr[64 * j]; u32x2 o; o.x = pk2(v[j].x * rstd * gg.x, v[j].y * rstd * gg.y); o.y = pk2(v[j].z * rstd * gg.z, v[j].w * rstd * gg.w); o8[64 * j] = o; }
}
__device__ __forceinline__ void p0_prologue(const Args& a, LAS unsigned char* lds) {
    const int tid = opaque_tid(), lane = tid & 63, wave = tid >> 6;
    LAS float* scr = (LAS float*)(lds + wave * 16640);
    const int gw = blockIdx.x * NWAVES + wave, NGW = gridDim.x * NWAVES;
    constexpr int I_IN = (D_ / 64) * (NPROJ / 64), I_UQ = (256 / 64) * (768 / 64), I_UKV = (128 / 64) * (1024 / 64), I_OUT = (D_ / 64) * (D_ / 64), I_UP = (D_ / 64) * (FF / 64), I_DN = (FF / 64) * (D_ / 64);
    constexpr int NITEMS = I_IN + I_UQ + I_UKV + I_OUT + I_UP + I_DN;
    unsigned char* ws = a.ws;
    for (int it = gw; it < NITEMS; it += NGW) {
        int r = it;
        if (r < I_IN) { transpose_item(a.w_in, D_, INW, (bf16*)(ws + WS_WIN), nullptr, scr, r, NPROJ / 64, lane); continue; } r -= I_IN;
        if (r < I_UQ) { transpose_item(a.w_uq, 256, 768, (bf16*)(ws + WS_WUQ), a.q_a_g, scr, r, 768 / 64, lane); continue; } r -= I_UQ;
        if (r < I_UKV) { transpose_item(a.w_ukv, 128, 1024, (bf16*)(ws + WS_WUKV), a.kv_a_g, scr, r, 1024 / 64, lane); continue; } r -= I_UKV;
        if (r < I_OUT) { transpose_item(a.w_out, D_, D_, (bf16*)(ws + WS_WOUT), (64 * (r / (D_ / 64)) < 512) ? a.attn_out_g : a.ssm_norm_g - 512, scr, r, D_ / 64, lane); continue; } r -= I_OUT;
        if (r < I_UP) { transpose_item(a.w_up, D_, FF, (bf16*)(ws + WS_WUP), a.ln_mlp_g, scr, r, FF / 64, lane); continue; } r -= I_UP;
        transpose_item(a.w_dn, FF, D_, (bf16*)(ws + WS_WDN), nullptr, scr, r, D_ / 64, lane);
    }
    bf16* H = (bf16*)(ws + WS_HB);
    for (int m = gw; m < T_; m += NGW) rms_row_to_bf16(a.x + (size_t)m * D_, a.ln_mix_g, H + (size_t)m * D_, lane);
    { float* ssq = (float*)(ws + WS_SSQ); float* sa = (float*)(ws + WS_SSQA); float* sy = (float*)(ws + WS_SSQY);
      for (int i = blockIdx.x * NTHREADS + tid; i < T_; i += gridDim.x * NTHREADS) { ssq[i] = 0.f; sa[i] = 0.f; sy[2 * i] = 0.f; sy[2 * i + 1] = 0.f; } }
}

__device__ __forceinline__ void prep_conv(const Args& a, LAS unsigned char* lds) {
    const int tid = opaque_tid(), cg8 = tid & 63, tq = tid >> 6;
    const bf16* proj = (const bf16*)(a.ws + WS_PROJ);
    bf16* Xt = (bf16*)(a.ws + WS_XT); bf16* Bm = (bf16*)(a.ws + WS_BM); bf16* Cm = (bf16*)(a.ws + WS_CM); bf16* Btr = (bf16*)(a.ws + WS_BT);
    LAS bf16* tile = (LAS bf16*)lds;
    for (int item = blockIdx.x; item < NB * 32 * 2; item += gridDim.x) {
        const int half = item & 1, tb = (item >> 1) & 31, b = item >> 6;
        const int ch = half * 512 + cg8 * 8, t0 = tb * 64 + tq * 8;
        u32x4 rows[12];
#pragma unroll
        for (int k = 0; k < 12; ++k) { const int tt = t0 - 2 + k; rows[k] = (u32x4){0u, 0u, 0u, 0u}; if (tt >= 0 && tt < S_) rows[k] = *(const u32x4*)(proj + (size_t)(b * S_ + tt) * NPROJ + C_XBC + ch); }
        f32x2 w2[5][4], b2[4];
#pragma unroll
        for (int j = 0; j < 5; ++j) { const f32x4 w0 = *(const f32x4*)(a.conv_w + j * 1024 + ch), w1 = *(const f32x4*)(a.conv_w + j * 1024 + ch + 4);
            w2[j][0] = (f32x2){w0.x, w0.y}; w2[j][1] = (f32x2){w0.z, w0.w}; w2[j][2] = (f32x2){w1.x, w1.y}; w2[j][3] = (f32x2){w1.z, w1.w}; }
        { const f32x4 b0 = *(const f32x4*)(a.conv_b + ch), b1 = *(const f32x4*)(a.conv_b + ch + 4);
          b2[0] = (f32x2){b0.x, b0.y}; b2[1] = (f32x2){b0.z, b0.w}; b2[2] = (f32x2){b1.x, b1.y}; b2[3] = (f32x2){b1.z, b1.w}; }
        f32x2 xr[12][4];
#pragma unroll
        for (int k = 0; k < 12; ++k) { const u32x4 v = rows[k]; xr[k][0] = (f32x2){bflo(v.x), bfhi(v.x)}; xr[k][1] = (f32x2){bflo(v.y), bfhi(v.y)}; xr[k][2] = (f32x2){bflo(v.z), bfhi(v.z)}; xr[k][3] = (f32x2){bflo(v.w), bfhi(v.w)}; }
        __syncthreads();
#pragma unroll
        for (int i = 0; i < 8; ++i) {
            f32x2 o2[4];
#pragma unroll
            for (int q = 0; q < 4; ++q) o2[q] = b2[q];
#pragma unroll
            for (int j = 0; j < 5; ++j) { o2[0] += w2[j][0] * xr[i + j][0]; o2[1] += w2[j][1] * xr[i + j][1]; o2[2] += w2[j][2] * xr[i + j][2]; o2[3] += w2[j][3] * xr[i + j][3]; }
            unsigned pw[4];
#pragma unroll
            for (int q = 0; q < 4; ++q) { const f32x2 tneg = o2[q] * (-LOG2E); f32x2 d; d.x = __builtin_amdgcn_exp2f(tneg.x); d.y = __builtin_amdgcn_exp2f(tneg.y); d = d + 1.0f;
                f32x2 rc; rc.x = __builtin_amdgcn_rcpf(d.x); rc.y = __builtin_amdgcn_rcpf(d.y); const f32x2 res = o2[q] * rc; pw[q] = pk2(res.x, res.y); }
            if (half == 0) {
#pragma unroll
                for (int q = 0; q < 4; ++q) { tile[(cg8 * 8 + 2 * q) * 66 + tq * 8 + i] = (bf16)(pw[q] & 0xffffu); tile[(cg8 * 8 + 2 * q + 1) * 66 + tq * 8 + i] = (bf16)(pw[q] >> 16); }
            } else {
                const int k = cg8 >> 4, isC = k >> 1, g = k & 1, n = (cg8 & 15) * 8;
                bf16* dst = (isC ? Cm : Bm) + ((size_t)(b * 2 + g) * S_ + t0 + i) * 128 + n;
                *(u32x4*)dst = (u32x4){pw[0], pw[1], pw[2], pw[3]};
                if (cg8 < 32) {
#pragma unroll
                    for (int q = 0; q < 4; ++q) { tile[(cg8 * 8 + 2 * q) * 66 + tq * 8 + i] = (bf16)(pw[q] & 0xffffu); tile[(cg8 * 8 + 2 * q + 1) * 66 + tq * 8 + i] = (bf16)(pw[q] >> 16); } }
            }
        }
        __syncthreads();
        {
            const int c8 = tid & 7;
#pragma unroll
            for (int k = 0; k < 8; ++k) { const int row = (tid >> 3) + 64 * k;
                if (half == 0 || k < 4) {
                    const LAS unsigned* src = (const LAS unsigned*)(tile + row * 66 + c8 * 8);
                    u32x4 o; o.x = src[0]; o.y = src[1]; o.z = src[2]; o.w = src[3];
                    bf16* dst = (half == 0 ? Xt + ((size_t)b * 512 + row) * S_ : Btr + ((size_t)b * 256 + row) * S_) + tb * 64 + 8 * c8;
                    *(u32x4*)dst = o; } }
        }
    }
    __syncthreads();
}
__device__ __forceinline__ float softplus(float v) { return v > 20.f ? v : log1pf(__expf(v)); }
__device__ __forceinline__ void prep_scan(const Args& a, LAS unsigned char* lds) {
    const int tid = opaque_tid(), lane = tid & 63, wave = tid >> 6;
    const float* dtraw = (const float*)(a.ws + WS_DTRAW);
    float* vec = (float*)(a.ws + WS_VEC);
    const size_t VS = (size_t)NB * 8 * S_;
    LAS float* red = (LAS float*)lds;
    for (int item = (int)gridDim.x - 1 - (int)blockIdx.x; item < NB * 8; item += gridDim.x) {
        const int b = item >> 3, hd = item & 7;
        float* vb = vec + ((size_t)b * 8 + hd) * S_;
        const float af_c = -__expf(a.a_log_f[hd]) * LOG2E, ab_c = -__expf(a.a_log_b[hd]) * LOG2E;
        const float bf_ = a.dt_bias_f[hd], bb_ = a.dt_bias_b[hd];
        const int t0 = tid * 4;
        float dtf[4], dtb[4], pf[4], pb[4]; float sf = 0.f, sb = 0.f;
#pragma unroll
        for (int i = 0; i < 4; ++i) { const float* p = dtraw + (size_t)(b * S_ + t0 + i) * 16; dtf[i] = softplus(p[hd] + bf_); dtb[i] = softplus(p[8 + hd] + bb_); }
#pragma unroll
        for (int i = 0; i < 4; ++i) { pb[i] = sb; sf += dtf[i] * af_c; sb += dtb[i] * ab_c; pf[i] = sf; }
        float incf = sf, incb = sb;
#pragma unroll
        for (int o = 1; o < 64; o <<= 1) { const float uf = __shfl_up(incf, o), ub = __shfl_up(incb, o); if (lane >= o) { incf += uf; incb += ub; } }
        __syncthreads();
        if (lane == 63) { red[wave] = incf; red[8 + wave] = incb; }
        __syncthreads();
        float offf = 0.f, offb = 0.f, TOTB = 0.f;
#pragma unroll
        for (int w2 = 0; w2 < 8; ++w2) { const float vf = red[w2], vbb = red[8 + w2]; if (w2 < wave) { offf += vf; offb += vbb; } TOTB += vbb; }
        incf += offf; incb += offb;
        const float afK0 = __shfl(incf, lane | 15);
        const float rbK0 = TOTB - __shfl(incb - sb, lane & ~15);
        const float afK1 = __shfl(incf, 63);
        const float rbK1 = TOTB - __shfl(incb - sb, 0);
        const float basef = incf - sf, baseb = incb - sb;
        f32x4 o_af, o_rb, o_vtf, o_vtb, o_dtf, o_dtb, o_wf, o_wb;
#pragma unroll
        for (int i = 0; i < 4; ++i) { const float af = basef + pf[i], rb = TOTB - (baseb + pb[i]);
            o_af[i] = af; o_rb[i] = rb; o_vtf[i] = ex2(afK0 - af) * dtf[i]; o_vtb[i] = ex2(rbK0 - rb) * dtb[i]; o_dtf[i] = dtf[i]; o_dtb[i] = dtb[i]; o_wf[i] = ex2(afK1 - af) * dtf[i]; o_wb[i] = ex2(rbK1 - rb) * dtb[i]; }
        *(f32x4*)(vb + 0 * VS + t0) = o_af; *(f32x4*)(vb + 1 * VS + t0) = o_rb; *(f32x4*)(vb + 2 * VS + t0) = o_vtf; *(f32x4*)(vb + 3 * VS + t0) = o_vtb;
        *(f32x4*)(vb + 4 * VS + t0) = o_dtf; *(f32x4*)(vb + 5 * VS + t0) = o_dtb;
        *(f32x4*)(vb + 6 * VS + t0) = o_wf; *(f32x4*)(vb + 7 * VS + t0) = o_wb;
    }
    __syncthreads();
}

#define DPPF(oldv, srcv, ctrl, rmask) __builtin_bit_cast(float, __builtin_amdgcn_update_dpp(__builtin_bit_cast(int, (float)(oldv)), __builtin_bit_cast(int, (float)(srcv)), (ctrl), (rmask), 0xF, false))
__device__ __forceinline__ float sum8_dpp(float v) {
    v += DPPF(0.f, v, 0xB1, 0xF); v += DPPF(0.f, v, 0x4E, 0xF); v += DPPF(0.f, v, 0x141, 0xF); return v; }
__device__ __forceinline__ float wave_sum_dpp(float v) {
    v = sum8_dpp(v); v += DPPF(0.f, v, 0x140, 0xF);
    v += DPPF(0.f, v, 0x142, 0xA); v += DPPF(0.f, v, 0x143, 0xC);
    return __builtin_bit_cast(float, __builtin_amdgcn_readlane(__builtin_bit_cast(int, v), 63)); }
__device__ __forceinline__ float xor4_dpp(float x, bool lo) {
    const float a = DPPF(0.f, x, 0x104, 0xF), b = DPPF(0.f, x, 0x114, 0xF); return lo ? a : b; }
__device__ __forceinline__ void sincos_rev(float ang, float& sn, float& cs) {
    const double r = (double)ang * 0.15915494309189533577; const float fr = (float)(r - __builtin_rint(r));
    sn = __builtin_amdgcn_sinf(fr); cs = __builtin_amdgcn_cosf(fr);
}
__device__ __forceinline__ void p3_qkv(const Args& a, LAS unsigned char* lds) {
    const int tid = opaque_tid(), lane = tid & 63, wave = tid >> 6, hd = lane >> 3, sub = lane & 7;
    const bf16* proj = (const bf16*)(a.ws + WS_PROJ); const bf16* qraw = (const bf16*)(a.ws + WS_QRAW); const bf16* kvraw = (const bf16*)(a.ws + WS_KVRAW);
    bf16* Q = (bf16*)(a.ws + WS_HB); bf16* Kk = (bf16*)(a.ws + WS_K); bf16* Vt = (bf16*)(a.ws + WS_VT);
    LAS bf16* vtile = (LAS bf16*)lds;
    const float qscale = 0.10206207261596577f * LOG2E;
    float gq[12], gk[12], ifr[4];
#pragma unroll
    for (int jj = 0; jj < 3; ++jj)
#pragma unroll
        for (int e = 0; e < 4; ++e) { gq[4 * jj + e] = a.q_norm_g[4 * sub + 32 * jj + e] * qscale; gk[4 * jj + e] = a.k_norm_g[4 * sub + 32 * jj + e]; }
#pragma unroll
    for (int e = 0; e < 4; ++e) ifr[e] = exp2f(-(float)(2 * (4 * (sub & 3) + e)) * (13.287712379549449f / 32.f));
    const float sgn = (sub < 4) ? -1.f : 1.f;
    for (int item = blockIdx.x; item < T_ / 64; item += gridDim.x) {
        __syncthreads();
        for (int i0 = 0; i0 < 8; i0 += 4) {
          u32x2 cq_[4], q0_[4], q1_[4], q2_[4], k0_[4], k1_[4], k2_[4]; unsigned ckv_[4]; u32x4 vv_[4]; int pos_[4];
#pragma unroll
          for (int u = 0; u < 4; ++u) {
            const int t = item * 64 + wave * 8 + i0 + u; const bf16* pr = proj + (size_t)t * NPROJ;
            cq_[u] = *(const u32x2*)(pr + C_CQ + 4 * lane); ckv_[u] = *(const unsigned*)(pr + C_CKV + 2 * lane);
            q0_[u] = *(const u32x2*)(qraw + (size_t)t * 768 + hd * 96 + 4 * sub); q1_[u] = *(const u32x2*)(qraw + (size_t)t * 768 + hd * 96 + 4 * sub + 32); q2_[u] = *(const u32x2*)(qraw + (size_t)t * 768 + hd * 96 + 4 * sub + 64);
            k0_[u] = *(const u32x2*)(kvraw + (size_t)t * 1024 + hd * 128 + 4 * sub); k1_[u] = *(const u32x2*)(kvraw + (size_t)t * 1024 + hd * 128 + 4 * sub + 32); k2_[u] = *(const u32x2*)(pr + C_KPE + 4 * sub);
            vv_[u] = *(const u32x4*)(kvraw + (size_t)t * 1024 + hd * 128 + 64 + 8 * sub); pos_[u] = a.pos[t];
          }
#pragma unroll
          for (int u = 0; u < 4; ++u) {
            const int tl = wave * 8 + i0 + u, t = item * 64 + tl, b = t / S_, s = t % S_;
            const u32x2 cq = cq_[u], q0 = q0_[u], q1 = q1_[u], q2 = q2_[u], k0 = k0_[u], k1 = k1_[u], k2 = k2_[u]; const unsigned ckv = ckv_[u]; const u32x4 vv = vv_[u];
            float sq = bflo(cq.x) * bflo(cq.x) + bfhi(cq.x) * bfhi(cq.x) + bflo(cq.y) * bflo(cq.y) + bfhi(cq.y) * bfhi(cq.y);
            float sk = bflo(ckv) * bflo(ckv) + bfhi(ckv) * bfhi(ckv);
            const float rq = __builtin_amdgcn_rsqf(wave_sum_dpp(sq) * (1.f / 256.f) + EPS), rk = __builtin_amdgcn_rsqf(wave_sum_dpp(sk) * (1.f / 128.f) + EPS);
            const float p = (float)pos_[u];
            float sn[4], cs[4];
#pragma unroll
            for (int e = 0; e < 4; ++e) sincos_rev(p * ifr[e], sn[e], cs[e]);
            float v[12];
            v[0] = bflo(q0.x); v[1] = bfhi(q0.x); v[2] = bflo(q0.y); v[3] = bfhi(q0.y); v[4] = bflo(q1.x); v[5] = bfhi(q1.x); v[6] = bflo(q1.y); v[7] = bfhi(q1.y);
            v[8] = bflo(q2.x); v[9] = bfhi(q2.x); v[10] = bflo(q2.y); v[11] = bfhi(q2.y);
            float ss = 0.f;
#pragma unroll
            for (int j = 0; j < 12; ++j) { v[j] *= rq; ss += v[j] * v[j]; }
            ss = sum8_dpp(ss);
            float rn = __builtin_amdgcn_rsqf(ss * (1.f / 96.f) + EPS);
#pragma unroll
            for (int j = 0; j < 12; ++j) v[j] = v[j] * rn * gq[j];
#pragma unroll
            for (int e = 0; e < 4; ++e) { const float x = v[8 + e], pt = xor4_dpp(x, sub < 4); v[8 + e] = x * cs[e] + sgn * pt * sn[e]; }
            { bf16* qo = Q + ((size_t)(b * 8 + hd) * S_ + s) * 96 + 4 * sub;
#pragma unroll
              for (int jj = 0; jj < 3; ++jj) { u32x2 o; o.x = pk2(v[4 * jj], v[4 * jj + 1]); o.y = pk2(v[4 * jj + 2], v[4 * jj + 3]); *(u32x2*)(qo + 32 * jj) = o; } }
            v[0] = bflo(k0.x) * rk; v[1] = bfhi(k0.x) * rk; v[2] = bflo(k0.y) * rk; v[3] = bfhi(k0.y) * rk; v[4] = bflo(k1.x) * rk; v[5] = bfhi(k1.x) * rk; v[6] = bflo(k1.y) * rk; v[7] = bfhi(k1.y) * rk;
            v[8] = bflo(k2.x); v[9] = bfhi(k2.x); v[10] = bflo(k2.y); v[11] = bfhi(k2.y);
            ss = 0.f;
#pragma unroll
            for (int j = 0; j < 12; ++j) ss += v[j] * v[j];
            ss = sum8_dpp(ss);
            rn = __builtin_amdgcn_rsqf(ss * (1.f / 96.f) + EPS);
#pragma unroll
            for (int j = 0; j < 12; ++j) v[j] = v[j] * rn * gk[j];
#pragma unroll
            for (int e = 0; e < 4; ++e) { const float x = v[8 + e], pt = xor4_dpp(x, sub < 4); v[8 + e] = x * cs[e] + sgn * pt * sn[e]; }
            { bf16* ko = Kk + ((size_t)(b * 8 + hd) * S_ + s) * 96 + 4 * sub;
#pragma unroll
              for (int jj = 0; jj < 3; ++jj) { u32x2 o; o.x = pk2(v[4 * jj], v[4 * jj + 1]); o.y = pk2(v[4 * jj + 2], v[4 * jj + 3]); *(u32x2*)(ko + 32 * jj) = o; } }
            { LAS bf16* vt = vtile + (hd * 64 + 8 * sub) * 66 + tl;
              const unsigned p0 = pk2(bflo(vv.x) * rk, bfhi(vv.x) * rk), p1 = pk2(bflo(vv.y) * rk, bfhi(vv.y) * rk), p2 = pk2(bflo(vv.z) * rk, bfhi(vv.z) * rk), p3 = pk2(bflo(vv.w) * rk, bfhi(vv.w) * rk);
              vt[0 * 66] = (bf16)(p0 & 0xffffu); vt[1 * 66] = (bf16)(p0 >> 16); vt[2 * 66] = (bf16)(p1 & 0xffffu); vt[3 * 66] = (bf16)(p1 >> 16);
              vt[4 * 66] = (bf16)(p2 & 0xffffu); vt[5 * 66] = (bf16)(p2 >> 16); vt[6 * 66] = (bf16)(p3 & 0xffffu); vt[7 * 66] = (bf16)(p3 >> 16); }
          }
        }
        __syncthreads();
        { const int b = (item * 64) / S_, s0 = (item * 64) % S_; const int c8 = tid & 7;
#pragma unroll
          for (int k = 0; k < 8; ++k) { const int row = (tid >> 3) + 64 * k;
              const LAS unsigned* src = (const LAS unsigned*)(vtile + row * 66 + c8 * 8);
              u32x4 o; o.x = src[0]; o.y = src[1]; o.z = src[2]; o.w = src[3];
              *(u32x4*)(Vt + ((size_t)b * 512 + row) * S_ + s0 + 8 * c8) = o; } }
    }
    __syncthreads();
}
__device__ __forceinline__ short __attribute__((ext_vector_type(8))) scale8(const short __attribute__((ext_vector_type(8))) x, const f32x4 w0, const f32x4 w1) {
    const u32x4 v = __builtin_bit_cast(u32x4, x); u32x4 o;
    o.x = pk2(bflo(v.x) * w0.x, bfhi(v.x) * w0.y); o.y = pk2(bflo(v.y) * w0.z, bfhi(v.y) * w0.w); o.z = pk2(bflo(v.z) * w1.x, bfhi(v.z) * w1.y); o.w = pk2(bflo(v.w) * w1.z, bfhi(v.w) * w1.w);
    return __builtin_bit_cast(short __attribute__((ext_vector_type(8))), o);
}
__device__ __forceinline__ void ssd_chunk_states(const Args& a, LAS unsigned char* lds) {
    const int tid = opaque_tid(), lane = tid & 63, w = tid >> 6, r = lane & 31, hh = lane >> 5;
    const int nblk = w & 3, pblk = w >> 2;
    const bf16* Bt = (const bf16*)(a.ws + WS_BT); const bf16* Xt = (const bf16*)(a.ws + WS_XT);
    const float* vec = (const float*)(a.ws + WS_VEC);
    const size_t VS = (size_t)NB * 8 * S_;
    bf16* Sst = (bf16*)a.out;
    constexpr int ROWB = 528, XOFF = 128 * ROWB, WOFF = XOFF + 64 * ROWB;
    LAS float* wl = (LAS float*)(lds + WOFF);
    const int crow = tid >> 5, cc = tid & 31;
    for (int item = blockIdx.x; item < NB * 8 * 8; item += gridDim.x) {
        const int qb = item & 7, head = (item >> 3) & 7, b = item >> 6, g = head >> 2;
        const int L0 = qb * 256;
        const bf16* Ab = Bt + (size_t)(b * 2 + g) * 128 * S_ + L0;
        const bf16* Xb = Xt + (size_t)(b * 8 + head) * 64 * S_ + L0;
        u32x4 st[12];
#pragma unroll
        for (int i = 0; i < 8; ++i) st[i] = *(const u32x4*)(Ab + (size_t)(16 * i + crow) * S_ + 8 * cc);
#pragma unroll
        for (int i = 0; i < 4; ++i) st[8 + i] = *(const u32x4*)(Xb + (size_t)(16 * i + crow) * S_ + 8 * cc);
        const float wv = vec[(6 + (tid >> 8)) * VS + ((size_t)b * 8 + head) * S_ + L0 + (tid & 255)];
        __syncthreads();
#pragma unroll
        for (int i = 0; i < 8; ++i) *(LAS u32x4*)(lds + (16 * i + crow) * ROWB + 16 * cc) = st[i];
#pragma unroll
        for (int i = 0; i < 4; ++i) *(LAS u32x4*)(lds + XOFF + (16 * i + crow) * ROWB + 16 * cc) = st[8 + i];
        wl[tid] = wv;
        __syncthreads();
        f32x16 accf, accb;
#pragma unroll
        for (int i = 0; i < 16; ++i) { accf[i] = 0.f; accb[i] = 0.f; }
        const LAS unsigned char* ap = lds + (32 * nblk + r) * ROWB + 16 * hh;
        const LAS unsigned char* xp = lds + XOFF + (32 * pblk + r) * ROWB + 16 * hh;
#pragma unroll
        for (int u = 0; u < 16; ++u) {
            const bf16x8 A = *(const LAS bf16x8*)(ap + 32 * u), X = *(const LAS bf16x8*)(xp + 32 * u);
            const f32x4 F0 = *(const LAS f32x4*)(wl + 16 * u + 8 * hh), F1 = *(const LAS f32x4*)(wl + 16 * u + 8 * hh + 4);
            const f32x4 G0 = *(const LAS f32x4*)(wl + 256 + 16 * u + 8 * hh), G1 = *(const LAS f32x4*)(wl + 256 + 16 * u + 8 * hh + 4);
            accf = MFMA32(A, scale8(X, F0, F1), accf); accb = MFMA32(A, scale8(X, G0, G1), accb);
        }
        bf16* of = Sst + ((((size_t)(b * 8 + head) * 2 + 0) * 8 + qb) * 64 + 32 * pblk + r) * 128 + 32 * nblk + 4 * hh;
        bf16* ob = of + (size_t)8 * 64 * 128;
#pragma unroll
        for (int g4 = 0; g4 < 4; ++g4) {
            u32x2 v; v.x = pk2(accf[4 * g4], accf[4 * g4 + 1]); v.y = pk2(accf[4 * g4 + 2], accf[4 * g4 + 3]); *(u32x2*)(of + 8 * g4) = v;
            u32x2 q; q.x = pk2(accb[4 * g4], accb[4 * g4 + 1]); q.y = pk2(accb[4 * g4 + 2], accb[4 * g4 + 3]); *(u32x2*)(ob + 8 * g4) = q; }
    }
    __syncthreads();
}
__device__ __forceinline__ void ssd_state_scan(const Args& a) {
    const int tid = opaque_tid();
    const float* vec = (const float*)(a.ws + WS_VEC);
    const size_t VS = (size_t)NB * 8 * S_;
    const bf16* Sst = (const bf16*)a.out; bf16* Hst = (bf16*)a.out + HST_OFF;
    for (int e = blockIdx.x * NTHREADS + tid; e < NB * 8 * 2 * 1024; e += gridDim.x * NTHREADS) {
        const int seq = e >> 10, off = (e & 1023) * 8, dir = seq & 1, bh = seq >> 1;
        const float* vb = vec + (size_t)bh * S_;
        const size_t base = (size_t)seq * 8 * 8192 + off;
        u32x4 sv[8]; float dec[8];
#pragma unroll
        for (int i = 0; i < 8; ++i) { const int qb = dir ? 7 - i : i; sv[i] = *(const u32x4*)(Sst + base + (size_t)qb * 8192);
            const int L0 = qb * 256, L1 = L0 + 255;
            if (dir == 0) dec[i] = ex2(vb[L1] - (qb ? vb[L0 - 1] : 0.f)); else dec[i] = ex2(vb[VS + L0] - (qb < 7 ? vb[VS + L1 + 1] : 0.f)); }
        float h[8];
#pragma unroll
        for (int k = 0; k < 8; ++k) h[k] = 0.f;
#pragma unroll
        for (int i = 0; i < 8; ++i) { const int qb = dir ? 7 - i : i;
            u32x4 o; o.x = pk2(h[0], h[1]); o.y = pk2(h[2], h[3]); o.z = pk2(h[4], h[5]); o.w = pk2(h[6], h[7]);
            *(u32x4*)(Hst + base + (size_t)qb * 8192) = o;
            const u32x4 v = sv[i]; const float d = dec[i];
            h[0] = h[0] * d + bflo(v.x); h[1] = h[1] * d + bfhi(v.x); h[2] = h[2] * d + bflo(v.y); h[3] = h[3] * d + bfhi(v.y);
            h[4] = h[4] * d + bflo(v.z); h[5] = h[5] * d + bfhi(v.z); h[6] = h[6] * d + bflo(v.w); h[7] = h[7] * d + bfhi(v.w); }
    }
}

__device__ __forceinline__ bf16x8 pack8(float a0, float a1, float a2, float a3, float a4, float a5, float a6, float a7) {
    u32x4 p; p.x = pk2(a0, a1); p.y = pk2(a2, a3); p.z = pk2(a4, a5); p.w = pk2(a6, a7); return __builtin_bit_cast(bf16x8, p);
}
__device__ __forceinline__ bf16x8 ld_vfrag(const LAS unsigned char* p) {
    return *(const LAS bf16x8*)p;
}
constexpr int AT_KROW = 208, AT_VROW = 144, AT_KBYTES = 64 * AT_KROW, AT_BUF = AT_KBYTES + 64 * AT_VROW;
__device__ __forceinline__ void attn_item(LAS unsigned char* lds, const bf16* Q, const bf16* Kg, const bf16* Vt, bf16* O, float* ssqa, int b, int h, int qb, float mb) {
    const int tid = opaque_tid(), lane = tid & 63, w = tid >> 6, r = lane & 31, hh = lane >> 5;
    const size_t bh = (size_t)(b * 8 + h);
    const int qrow = qb * 256 + w * 32 + r;
    bf16x8 qf[6];
    { const bf16* Qp = Q + (bh * S_ + qrow) * 96 + 8 * hh;
#pragma unroll
      for (int s = 0; s < 6; ++s) qf[s] = *(const bf16x8*)(Qp + 16 * s); }
    const unsigned char* Kp = (const unsigned char*)(Kg + bh * S_ * 96);
    const bf16* Vp = Vt + bh * 64 * S_;
    const int vrow = tid >> 3, vc8 = tid & 7;
    const int kc0 = tid, kc1 = tid + 512;
    const unsigned koff0 = (kc0 / 12) * AT_KROW + (kc0 % 12) * 16, koff1 = (kc1 / 12) * AT_KROW + (kc1 % 12) * 16;
    const unsigned voff = AT_KBYTES + vrow * AT_VROW + (vc8 >> 1) * 32 + (vc8 & 1) * 8;
    u32x4 kr0, kr1 = {0, 0, 0, 0}, vr;
#define AT_LOAD(j) do { kr0 = *(const u32x4*)(Kp + (size_t)(j) * 12288 + kc0 * 16); if (tid < 256) kr1 = *(const u32x4*)(Kp + (size_t)(j) * 12288 + kc1 * 16); \
        vr = *(const u32x4*)(Vp + (size_t)vrow * S_ + (j) * 64 + vc8 * 8); } while (0)
#define AT_STORE(buf) do { LAS unsigned char* bb = lds + (buf) * AT_BUF; *(LAS u32x4*)(bb + koff0) = kr0; if (tid < 256) *(LAS u32x4*)(bb + koff1) = kr1; \
        *(LAS u32x2*)(bb + voff) = (u32x2){vr.x, vr.y}; *(LAS u32x2*)(bb + voff + 16) = (u32x2){vr.z, vr.w}; } while (0)
    __syncthreads();
    AT_LOAD(0); AT_STORE(0);
    __syncthreads();
    f32x16 o0, o1, nmbv;
#pragma unroll
    for (int i = 0; i < 16; ++i) { o0[i] = 0.f; o1[i] = 0.f; nmbv[i] = -mb; }
    f32x2 ls2 = {0.f, 0.f};
    for (int j = 0; j < 32; ++j) {
        if (j + 1 < 32) AT_LOAD(j + 1);
        const LAS unsigned char* kb_ = lds + (j & 1) * AT_BUF;
        const LAS unsigned char* vb_ = kb_ + AT_KBYTES;
        bf16x8 kf[6];
#pragma unroll
        for (int s = 0; s < 6; ++s) kf[s] = *(const LAS bf16x8*)(kb_ + r * AT_KROW + 32 * s + 16 * hh);
#pragma unroll
        for (int kb = 0; kb < 2; ++kb) {
            f32x16 sT = MFMA32(kf[0], qf[0], nmbv);
#pragma unroll
            for (int s = 1; s < 6; ++s) sT = MFMA32(kf[s], qf[s], sT);
            bf16x8 vf[2][2];
#pragma unroll
            for (int ks = 0; ks < 2; ++ks) { vf[ks][0] = ld_vfrag(vb_ + r * AT_VROW + (2 * kb + ks) * 32 + 16 * hh); vf[ks][1] = ld_vfrag(vb_ + (32 + r) * AT_VROW + (2 * kb + ks) * 32 + 16 * hh); }
            if (kb == 0) {
#pragma unroll
                for (int s = 0; s < 6; ++s) kf[s] = *(const LAS bf16x8*)(kb_ + (32 + r) * AT_KROW + 32 * s + 16 * hh);
            }
            __builtin_amdgcn_sched_barrier(0);
#pragma unroll
            for (int i = 0; i < 16; i += 2) { sT[i] = ex2(sT[i]); sT[i + 1] = ex2(sT[i + 1]); ls2 += (f32x2){sT[i], sT[i + 1]}; }
            __builtin_amdgcn_sched_barrier(0);
#pragma unroll
            for (int ks = 0; ks < 2; ++ks) {
                const bf16x8 pf = pack8(sT[8 * ks], sT[8 * ks + 1], sT[8 * ks + 2], sT[8 * ks + 3], sT[8 * ks + 4], sT[8 * ks + 5], sT[8 * ks + 6], sT[8 * ks + 7]);
                o0 = MFMA32(vf[ks][0], pf, o0); o1 = MFMA32(vf[ks][1], pf, o1);
            }
        }
        if (j + 1 < 32) AT_STORE((j + 1) & 1);
        __syncthreads();
    }
    float lsum = ls2.x + ls2.y;
#undef AT_LOAD
#undef AT_STORE
    lsum += __shfl_xor(lsum, 32);
    const float inv = 1.f / lsum;
    LAS unsigned char* img = lds + w * (32 * 272);
    { float sq = 0.f;
#pragma unroll
      for (int i = 0; i < 16; ++i) { const float p0 = o0[i] * inv, p1 = o1[i] * inv; sq += p0 * p0 + p1 * p1; }
      sq += __shfl_xor(sq, 32);
      if (hh == 0) atomicAdd(ssqa + (size_t)b * S_ + qrow, sq); }
#pragma unroll
    for (int g4 = 0; g4 < 4; ++g4) {
        *(LAS f32x4*)(img + r * 272 + (8 * g4 + 4 * hh) * 4) = (f32x4){o0[4 * g4] * inv, o0[4 * g4 + 1] * inv, o0[4 * g4 + 2] * inv, o0[4 * g4 + 3] * inv};
        *(LAS f32x4*)(img + r * 272 + (32 + 8 * g4 + 4 * hh) * 4) = (f32x4){o1[4 * g4] * inv, o1[4 * g4 + 1] * inv, o1[4 * g4 + 2] * inv, o1[4 * g4 + 3] * inv};
    }
    const int er = lane >> 3, ec = lane & 7;
#pragma unroll
    for (int k = 0; k < 4; ++k) {
        const f32x4 v0 = *(const LAS f32x4*)(img + (er + 8 * k) * 272 + ec * 32), v1 = *(const LAS f32x4*)(img + (er + 8 * k) * 272 + ec * 32 + 16);
        u32x4 o; o.x = pk2(v0[0], v0[1]); o.y = pk2(v0[2], v0[3]); o.z = pk2(v1[0], v1[1]); o.w = pk2(v1[2], v1[3]);
        *(u32x4*)(O + ((size_t)b * S_ + qb * 256 + w * 32 + er + 8 * k) * 1024 + h * 64 + 8 * ec) = o;
    }
}

constexpr int SD_BROW = 272, SD_XROW = 144, SD_BBYTES = 64 * SD_BROW, SD_XBYTES = 64 * SD_XROW, SD_VEC = SD_BBYTES + 2 * SD_XBYTES, SD_BUF = SD_VEC + 2 * 6 * 256;
__device__ __forceinline__ void ssd_item(LAS unsigned char* lds, const Args& a, int b, int hp, int qb) {
    const int tid = opaque_tid(), lane = tid & 63, w = tid >> 6, r = lane & 31, hh = lane >> 5;
    const int g = hp >> 1, h0 = hp * 2;
    const bf16* Bm = (const bf16*)(a.ws + WS_BM); const bf16* Cm = (const bf16*)(a.ws + WS_CM); const bf16* Xt = (const bf16*)(a.ws + WS_XT);
    const float* vec = (const float*)(a.ws + WS_VEC);
    const size_t VS = (size_t)NB * 8 * S_;
    const int l0 = qb * 256 + w * 32, l = l0 + r;
    bf16x8 cf[8];
    { const bf16* Cp = Cm + ((size_t)(b * 2 + g) * S_ + l) * 128 + 8 * hh;
#pragma unroll
      for (int s = 0; s < 8; ++s) cf[s] = *(const bf16x8*)(Cp + 16 * s); }
    float afl[2], rbl[2], dsk[2];
#pragma unroll
    for (int hd = 0; hd < 2; ++hd) { const float* vb = vec + ((size_t)b * 8 + h0 + hd) * S_; afl[hd] = vb[l]; rbl[hd] = vb[VS + l]; dsk[hd] = a.d_skip[h0 + hd]; }
    const unsigned char* Bp = (const unsigned char*)(Bm + (size_t)(b * 2 + g) * S_ * 128);
    const int xrow = tid >> 3, xc8 = tid & 7;
    const bf16* Xp0 = Xt + ((size_t)(b * 8 + h0) * 64 + xrow) * S_ + xc8 * 8;
    const bf16* Xp1 = Xp0 + (size_t)64 * S_;
    const int bc0 = tid, bc1 = tid + 512;
    const unsigned boff0 = (bc0 >> 4) * SD_BROW + (bc0 & 15) * 16, boff1 = (bc1 >> 4) * SD_BROW + (bc1 & 15) * 16;
    const unsigned xoff = SD_BBYTES + xrow * SD_XROW + (xc8 >> 1) * 32 + (xc8 & 1) * 8;
    const int vhd = tid / 96, vrem = tid % 96, varr = vrem >> 4, vc = vrem & 15;
    const float* vsrc = vec + (size_t)varr * VS + ((size_t)b * 8 + h0 + vhd) * S_ + 4 * vc;
    const unsigned voff = SD_VEC + ((vhd * 6 + varr) * 64 + 4 * vc) * 4;
    u32x4 br0, br1, xr0, xr1; f32x4 vr = {0.f, 0.f, 0.f, 0.f};
#define SD_LOAD(j) do { br0 = *(const u32x4*)(Bp + (size_t)(j) * 16384 + bc0 * 16); br1 = *(const u32x4*)(Bp + (size_t)(j) * 16384 + bc1 * 16); \
        xr0 = *(const u32x4*)(Xp0 + (j) * 64); xr1 = *(const u32x4*)(Xp1 + (j) * 64); if (tid < 192) vr = *(const f32x4*)(vsrc + (j) * 64); } while (0)
#define SD_STORE(buf) do { LAS unsigned char* bb = lds + (buf) * SD_BUF; *(LAS u32x4*)(bb + boff0) = br0; *(LAS u32x4*)(bb + boff1) = br1; \
        *(LAS u32x2*)(bb + xoff) = (u32x2){xr0.x, xr0.y}; *(LAS u32x2*)(bb + xoff + 16) = (u32x2){xr0.z, xr0.w}; \
        *(LAS u32x2*)(bb + xoff + SD_XBYTES) = (u32x2){xr1.x, xr1.y}; *(LAS u32x2*)(bb + xoff + SD_XBYTES + 16) = (u32x2){xr1.z, xr1.w}; \
        if (tid < 192) *(LAS f32x4*)(bb + voff) = vr; } while (0)
    const int j0 = qb * 4, j1 = j0 + 4;
    __syncthreads();
    SD_LOAD(j0); SD_STORE(j0 & 1);
    __syncthreads();
    f32x16 y[2][2], zero16;
#pragma unroll
    for (int i = 0; i < 16; ++i) zero16[i] = 0.f;
#pragma unroll
    for (int i = 0; i < 16; ++i) { y[0][0][i] = 0.f; y[0][1][i] = 0.f; y[1][0][i] = 0.f; y[1][1][i] = 0.f; }
    for (int j = j0; j < j1; ++j) {
        if (j + 1 < j1) SD_LOAD(j + 1);
        const LAS unsigned char* bb = lds + (j & 1) * SD_BUF;
        const int key0 = j * 64;
        const int type = (key0 + 63 < l0) ? 0 : ((key0 > l0 + 31) ? 1 : 2);
#pragma unroll
        for (int kb = 0; kb < 2; ++kb) {
            f32x16 sT;
#pragma unroll
            for (int i = 0; i < 16; ++i) sT[i] = 0.f;
#pragma unroll
            for (int s = 0; s < 8; ++s) { const bf16x8 bf_ = *(const LAS bf16x8*)(bb + (32 * kb + r) * SD_BROW + 32 * s + 16 * hh); sT = MFMA32(bf_, cf[s], sT); }
#pragma unroll
            for (int hd = 0; hd < 2; ++hd) {
                const LAS float* vv = (const LAS float*)(bb + SD_VEC + hd * 6 * 256);
                const LAS unsigned char* xb = bb + SD_BBYTES + hd * SD_XBYTES;
                float p[16];
                if (type != 2) {
                    const float coef = (type == 0) ? ex2(afl[hd] - vv[63]) : ex2(rbl[hd] - vv[64]);
                    const LAS float* vt = vv + (type == 0 ? 128 : 192) + 32 * kb + 4 * hh;
#pragma unroll
                    for (int g4 = 0; g4 < 4; ++g4) { const f32x4 t4 = *(const LAS f32x4*)(vt + 8 * g4);
#pragma unroll
                        for (int e = 0; e < 4; ++e) p[4 * g4 + e] = sT[4 * g4 + e] * (t4[e] * coef); }
                } else {
#pragma unroll
                    for (int g4 = 0; g4 < 4; ++g4) {
                        const int kk = 32 * kb + 8 * g4 + 4 * hh;
                        const f32x4 af4 = *(const LAS f32x4*)(vv + kk), rb4 = *(const LAS f32x4*)(vv + 64 + kk), df4 = *(const LAS f32x4*)(vv + 256 + kk), db4 = *(const LAS f32x4*)(vv + 320 + kk);
#pragma unroll
                        for (int e = 0; e < 4; ++e) {
                            const int s = key0 + kk + e;
                            const bool fwd = (s <= l);
                            const float arg = fwd ? (afl[hd] - af4[e]) : (rbl[hd] - rb4[e]);
                            float wgt = ex2(fminf(arg, 0.f)) * (fwd ? df4[e] : db4[e]);
                            if (s == l) wgt += db4[e];
                            float pv = sT[4 * g4 + e] * wgt;
                            if (s == l) pv += dsk[hd];
                            p[4 * g4 + e] = pv;
                        }
                        __builtin_amdgcn_sched_barrier(0);
                    }
                }
#pragma unroll
                for (int ks = 0; ks < 2; ++ks) {
                    const bf16x8 pf = pack8(p[8 * ks], p[8 * ks + 1], p[8 * ks + 2], p[8 * ks + 3], p[8 * ks + 4], p[8 * ks + 5], p[8 * ks + 6], p[8 * ks + 7]);
                    const bf16x8 x0 = ld_vfrag(xb + r * SD_XROW + (2 * kb + ks) * 32 + 16 * hh);
                    const bf16x8 x1 = ld_vfrag(xb + (32 + r) * SD_XROW + (2 * kb + ks) * 32 + 16 * hh);
                    y[hd][0] = MFMA32(x0, pf, y[hd][0]); y[hd][1] = MFMA32(x1, pf, y[hd][1]);
                }
            }
        }
        if (j + 1 < j1) SD_STORE((j + 1) & 1);
        __syncthreads();
    }
    {
        const bf16* Hst = (const bf16*)a.out + HST_OFF;
        const int Lb = qb * 256;
        u32x4 hreg[8];
#pragma unroll
        for (int tq = 0; tq < 4; ++tq)
#pragma unroll
            for (int i = 0; i < 2; ++i) { const int id = tid + 512 * i;
                hreg[2 * tq + i] = *(const u32x4*)(Hst + ((((size_t)(b * 8 + h0 + (tq >> 1)) * 2 + (tq & 1)) * 8 + qb) * 64) * 128 + (size_t)id * 8); }
#pragma unroll
        for (int tq = 0; tq < 4; ++tq)
#pragma unroll
            for (int i = 0; i < 2; ++i) { const int id = tid + 512 * i; *(LAS u32x4*)(lds + tq * (64 * 272) + (id >> 4) * 272 + (id & 15) * 16) = hreg[2 * tq + i]; }
        __syncthreads();
#pragma unroll
        for (int hd = 0; hd < 2; ++hd) {
            const float* vb = vec + ((size_t)b * 8 + h0 + hd) * S_;
            const float uf = ex2(afl[hd] - (qb ? vb[Lb - 1] : 0.f)), ub = ex2(rbl[hd] - (qb < 7 ? vb[VS + Lb + 256] : 0.f));
#pragma unroll
            for (int dir = 0; dir < 2; ++dir) {
                const LAS unsigned char* hp = lds + (hd * 2 + dir) * (64 * 272) + r * 272 + 16 * hh;
                const float uu = dir ? ub : uf;
#pragma unroll
                for (int db = 0; db < 2; ++db) {
                    f32x16 z = zero16;
#pragma unroll
                    for (int s = 0; s < 8; ++s) { const bf16x8 hf = *(const LAS bf16x8*)(hp + db * 32 * 272 + 32 * s); z = MFMA32(hf, cf[s], z); }
#pragma unroll
                    for (int i = 0; i < 16; ++i) y[hd][db][i] += uu * z[i];
                }
            }
        }
    }
#undef SD_LOAD
#undef SD_STORE
    const bf16* proj = (const bf16*)(a.ws + WS_PROJ); bf16* YG = (bf16*)(a.ws + WS_MIXRAW) + 512; float* ssqy = (float*)(a.ws + WS_SSQY);
    __syncthreads();
    LAS unsigned char* img = lds + w * (32 * 528);
#pragma unroll
    for (int hd = 0; hd < 2; ++hd)
#pragma unroll
        for (int db = 0; db < 2; ++db)
#pragma unroll
            for (int g4 = 0; g4 < 4; ++g4)
                *(LAS f32x4*)(img + r * 528 + (hd * 64 + 32 * db + 8 * g4 + 4 * hh) * 4) = (f32x4){y[hd][db][4 * g4], y[hd][db][4 * g4 + 1], y[hd][db][4 * g4 + 2], y[hd][db][4 * g4 + 3]};
    const int er = lane >> 4, ec = lane & 15;
    u32x4 zz[8];
#pragma unroll
    for (int k = 0; k < 8; ++k) zz[k] = *(const u32x4*)(proj + ((size_t)b * S_ + l0 + er + 4 * k) * NPROJ + C_Z + h0 * 64 + 8 * ec);
#pragma unroll
    for (int k = 0; k < 8; ++k) {
        const f32x4 v0 = *(const LAS f32x4*)(img + (er + 4 * k) * 528 + ec * 32), v1 = *(const LAS f32x4*)(img + (er + 4 * k) * 528 + ec * 32 + 16);
        const u32x4 z = zz[k]; u32x4 o;
        const float g0 = v0[0] * silu(bflo(z.x)), g1 = v0[1] * silu(bfhi(z.x)), g2 = v0[2] * silu(bflo(z.y)), g3 = v0[3] * silu(bfhi(z.y));
        const float g4_ = v1[0] * silu(bflo(z.z)), g5 = v1[1] * silu(bfhi(z.z)), g6 = v1[2] * silu(bflo(z.w)), g7 = v1[3] * silu(bfhi(z.w));
        o.x = pk2(g0, g1); o.y = pk2(g2, g3); o.z = pk2(g4_, g5); o.w = pk2(g6, g7);
        *(u32x4*)(YG + ((size_t)b * S_ + l0 + er + 4 * k) * 1024 + h0 * 64 + 8 * ec) = o;
        float sq = (g0 * g0 + g1 * g1) + (g2 * g2 + g3 * g3) + (g4_ * g4_ + g5 * g5) + (g6 * g6 + g7 * g7);
        sq += __shfl_xor(sq, 1); sq += __shfl_xor(sq, 2); sq += __shfl_xor(sq, 4); sq += __shfl_xor(sq, 8);
        if (ec == 0) atomicAdd(ssqy + 2 * ((size_t)b * S_ + l0 + er + 4 * k) + g, sq);
    }
}

__device__ __forceinline__ void p5_mix(const Args& a) {
    const int tid = opaque_tid(), lane = tid & 63, wave = tid >> 6;
    const int gw = blockIdx.x * NWAVES + wave, NGW = gridDim.x * NWAVES;
    const bf16* AO = (const bf16*)(a.ws + WS_ATTNO); const bf16* YG = (const bf16*)(a.ws + WS_YG); bf16* MIX = (bf16*)(a.ws + WS_HB);
    float ga[8], gs[8];
#pragma unroll
    for (int e = 0; e < 8; ++e) { ga[e] = a.attn_out_g[8 * lane + e]; gs[e] = a.ssm_norm_g[8 * lane + e]; }
    for (int t0 = gw; t0 < T_; t0 += 4 * NGW) {
        u32x4 avv[4], yvv[4];
#pragma unroll
        for (int u = 0; u < 4; ++u) { const int t = t0 + u * NGW; if (t < T_) { avv[u] = *(const u32x4*)(AO + (size_t)t * 512 + 8 * lane); yvv[u] = *(const u32x4*)(YG + (size_t)t * 512 + 8 * lane); } else { avv[u] = (u32x4){0u, 0u, 0u, 0u}; yvv[u] = avv[u]; } }
#pragma unroll
        for (int u = 0; u < 4; ++u) {
        const int t = t0 + u * NGW; if (t >= T_) break;
        const u32x4 av = avv[u], yv = yvv[u];
        float x[8], yy[8];
        x[0] = bflo(av.x); x[1] = bfhi(av.x); x[2] = bflo(av.y); x[3] = bfhi(av.y); x[4] = bflo(av.z); x[5] = bfhi(av.z); x[6] = bflo(av.w); x[7] = bfhi(av.w);
        yy[0] = bflo(yv.x); yy[1] = bfhi(yv.x); yy[2] = bflo(yv.y); yy[3] = bfhi(yv.y); yy[4] = bflo(yv.z); yy[5] = bfhi(yv.z); yy[6] = bflo(yv.w); yy[7] = bfhi(yv.w);
        float sa = 0.f, sy = 0.f;
#pragma unroll
        for (int e = 0; e < 8; ++e) { sa += x[e] * x[e]; sy += yy[e] * yy[e]; }
        sa = wave_sum(sa);
#pragma unroll
        for (int o = 1; o < 32; o <<= 1) sy += __shfl_xor(sy, o);
        const float ra = 1.f / sqrtf(sa * (1.f / 512.f) + EPS), ry = 1.f / sqrtf(sy * (1.f / 256.f) + EPS);
        u32x4 oa, oy;
        oa.x = pk2(x[0] * ra * ga[0], x[1] * ra * ga[1]); oa.y = pk2(x[2] * ra * ga[2], x[3] * ra * ga[3]); oa.z = pk2(x[4] * ra * ga[4], x[5] * ra * ga[5]); oa.w = pk2(x[6] * ra * ga[6], x[7] * ra * ga[7]);
        oy.x = pk2(yy[0] * ry * gs[0], yy[1] * ry * gs[1]); oy.y = pk2(yy[2] * ry * gs[2], yy[3] * ry * gs[3]); oy.z = pk2(yy[4] * ry * gs[4], yy[5] * ry * gs[5]); oy.w = pk2(yy[6] * ry * gs[6], yy[7] * ry * gs[7]);
        *(u32x4*)(MIX + (size_t)t * D_ + 8 * lane) = oa; *(u32x4*)(MIX + (size_t)t * D_ + 512 + 8 * lane) = oy;
    }
        }
}

#define XB_TMO      128
#define XB_XCNT(j)  (256  + 64 * (j))
#define XB_XSUB(j)  (1280 + 64 * (j))
#define XB_XGEN(j)  (2304 + 64 * (j))
#define XB_TOP      3328
#define XB_TOPGEN   3392
#define XCD_BAR_WORDS 3456
#define XB_SPIN_CAP (1u << 18)

__device__ __forceinline__ unsigned xb_ld(unsigned* p)              { return __hip_atomic_load(p, __ATOMIC_RELAXED, __HIP_MEMORY_SCOPE_AGENT); }
__device__ __forceinline__ unsigned xb_add(unsigned* p, unsigned v) { return __hip_atomic_fetch_add(p, v, __ATOMIC_RELAXED, __HIP_MEMORY_SCOPE_AGENT); }
__device__ __forceinline__ unsigned xb_xcc_id() { return (unsigned)__builtin_amdgcn_s_getreg((3 << 11) | 20) & 0xFu; }
#define XB_SPIN(cond, bar) do { unsigned _sp = 0; while (cond) { __builtin_amdgcn_s_sleep(1); \
    if ((++_sp & 255u) == 0u) { if (xb_ld(&(bar)[XB_TMO])) break; if (_sp > XB_SPIN_CAP) { atomicAdd(&(bar)[XB_TMO], 1u); break; } } } } while (0)

struct XcdBarrier {
    unsigned* bar; unsigned x;
    volatile LAS unsigned* st;
};

__device__ __forceinline__ XcdBarrier xcd_barrier_post(unsigned* bar, volatile LAS unsigned* st) {
    XcdBarrier b; b.bar = bar; b.x = xb_xcc_id(); b.st = st;
    if (threadIdx.x == 0) (void)xb_add(&bar[XB_XCNT(b.x)], 1u);
    return b;
}
__device__ __forceinline__ void xcd_barrier_complete(unsigned* bar, unsigned x, unsigned& nloc, unsigned& nx) {
    const unsigned G = gridDim.x * gridDim.y * gridDim.z;
    unsigned sum, cnt, mine, sp = 0u;
    for (;;) {
        sum = 0u; cnt = 0u; mine = 0u;
#pragma unroll
        for (unsigned j = 0; j < 16; ++j) { const unsigned c = xb_ld(&bar[XB_XCNT(j)]); sum += c; cnt += (c > 0u) ? 1u : 0u; mine = (j == x) ? c : mine; }
        if (sum == G) break;
        __builtin_amdgcn_s_sleep(1);
        if ((++sp & 255u) == 0u) { if (xb_ld(&bar[XB_TMO])) break; if (sp > XB_SPIN_CAP) { atomicAdd(&bar[XB_TMO], 1u); break; } }
    }
    nloc = mine > 0u ? mine : 1u; nx = cnt > 0u ? cnt : 1u;
}

__device__ __forceinline__ void xcd_barrier(const XcdBarrier& b) {
    asm volatile("s_waitcnt vmcnt(0)" ::: "memory");
    __syncthreads();
    if (threadIdx.x == 0) {
        unsigned* bar = b.bar;
        __builtin_amdgcn_s_waitcnt(0);
        unsigned nloc = b.st[0], nx = b.st[1];
        if (nloc == 0u) { xcd_barrier_complete(bar, b.x, nloc, nx); b.st[0] = nloc; b.st[1] = nx; }
        const unsigned old = xb_add(&bar[XB_XSUB(b.x)], 1u);
        const unsigned gen = old / nloc;
        if (old + 1u == (gen + 1u) * nloc) {
            __builtin_amdgcn_fence(__ATOMIC_RELEASE, "agent");
            asm volatile("s_waitcnt vmcnt(0)" ::: "memory");
            const unsigned og = xb_add(&bar[XB_TOP], 1u);
            const unsigned tg = og / nx;
            if (og + 1u == (tg + 1u) * nx) xb_add(&bar[XB_TOPGEN], 1u);
            else XB_SPIN(xb_ld(&bar[XB_TOPGEN]) == tg, bar);
            __builtin_amdgcn_fence(__ATOMIC_ACQUIRE, "agent");
            xb_add(&bar[XB_XGEN(b.x)], 1u);
            asm volatile("s_waitcnt vmcnt(0)" ::: "memory");
        } else {
            XB_SPIN(xb_ld(&bar[XB_XGEN(b.x)]) == gen, bar);
            __builtin_amdgcn_fence(__ATOMIC_ACQUIRE, "agent");
            asm volatile("s_waitcnt vmcnt(0)" ::: "memory");
        }
    }
    __syncthreads();
}

__device__ __forceinline__ void split_arrive(unsigned* cnt) {
    asm volatile("s_waitcnt vmcnt(0)" ::: "memory");
    __syncthreads();
    if (threadIdx.x == 0) { __builtin_amdgcn_fence(__ATOMIC_RELEASE, "agent"); asm volatile("s_waitcnt vmcnt(0)" ::: "memory"); (void)__hip_atomic_fetch_add(cnt, 1u, __ATOMIC_RELAXED, __HIP_MEMORY_SCOPE_AGENT); }
}
__device__ __forceinline__ void split_wait(unsigned* cnt, unsigned want) {
    if (threadIdx.x == 0) { unsigned sp = 0; while (__hip_atomic_load(cnt, __ATOMIC_RELAXED, __HIP_MEMORY_SCOPE_AGENT) < want) { __builtin_amdgcn_s_sleep(1); if (++sp > (1u << 22)) break; }
        __builtin_amdgcn_fence(__ATOMIC_ACQUIRE, "agent"); asm volatile("s_waitcnt vmcnt(0)" ::: "memory"); }
    __syncthreads();
}

#define REP_P0 1
#define REP_P23 1
#define REP_P5 1
#ifndef REP_P4
#define REP_P4 1
#endif
__global__ void __launch_bounds__(NTHREADS, 2) fwd_megakernel(Args a) {
    extern __shared__ __attribute__((aligned(16))) unsigned char lds_raw[];
    LAS unsigned char* lds = (LAS unsigned char*)lds_raw;
    cg::grid_group grid = cg::this_grid();
    unsigned char* ws = a.ws;
    const int G = gridDim.x, bx = blockIdx.x;
    const int tid = opaque_tid(), lane = tid & 63, wave = tid >> 6;
    volatile LAS unsigned* MISC = (volatile LAS unsigned*)(lds + MISC_OFF);
    if (threadIdx.x < 16) MISC[threadIdx.x] = 0u;
    __syncthreads();
    XcdBarrier bar = xcd_barrier_post((unsigned*)(ws + WS_BAR), MISC + 8);
#define GRID_BAR() xcd_barrier(bar)
    for (int rep = 0; rep < REP_P0; ++rep) {
    p0_prologue(a, lds);
    if (a.ws == nullptr) grid.sync();
    GRID_BAR();
    }
    { pg8::Gemm g{(const bf16*)(ws + WS_HB), (const bf16*)(ws + WS_WIN), T_, NPROJ, D_, D_}; pg8::StaticOrder S; S.init(T_, NPROJ, G, bx);
      pg8::EpiBf16<2> E{(bf16*)(ws + WS_PROJ), NPROJ, (float*)(ws + WS_DTRAW)};
      pg8::gemm_phase<pg8::EpiBf16<2>, pg8::StaticOrder, true, true>(lds, g, S, E); }
    GRID_BAR();
    for (int rep = 0; rep < REP_P23; ++rep) {
    { pg8::Gemm g{(const bf16*)(ws + WS_PROJ) + C_CQ, (const bf16*)(ws + WS_WUQ), T_, 768, 256, NPROJ}; pg8::StaticOrder S; S.init(T_, 768, G, bx);
      pg8::EpiBf16<0> E{(bf16*)(ws + WS_QRAW), 768, nullptr};
      pg8::gemm_phase<pg8::EpiBf16<0>, pg8::StaticOrder, true, true>(lds, g, S, E); }
    { pg8::Gemm g{(const bf16*)(ws + WS_PROJ) + C_CKV, (const bf16*)(ws + WS_WUKV), T_, 1024, 128, NPROJ}; pg8::StaticOrder S; S.init(T_, 1024, G, bx);
      pg8::EpiBf16<0> E{(bf16*)(ws + WS_KVRAW), 1024, nullptr};
      pg8::gemm_phase<pg8::EpiBf16<0>, pg8::StaticOrder, true, true>(lds, g, S, E); }
    prep_scan(a, lds);
    prep_conv(a, lds);
    GRID_BAR();
    p3_qkv(a, lds);
    ssd_chunk_states(a, lds);
    GRID_BAR();
    }
    for (int rep = 0; rep < REP_P4; ++rep) {
        float mq = 0.f, mk = 0.f;
        for (int i = 0; i < 96; ++i) { mq = fmaxf(mq, fabsf(a.q_norm_g[i])); mk = fmaxf(mk, fabsf(a.k_norm_g[i])); }
        const float mb = fminf(96.f * mq * mk * 0.10206207261596577f * LOG2E, 80.f);
        unsigned* s2cnt = (unsigned*)(ws + WS_BAR) + XCD_BAR_WORDS + 64;
        ssd_state_scan(a);
        split_arrive(s2cnt);
        for (int u = bx; u < 512; u += G) { const int qb = u & 7, h = (u >> 3) & 7, b = u >> 6; attn_item(lds, (const bf16*)(ws + WS_HB), (const bf16*)(ws + WS_K), (const bf16*)(ws + WS_VT), (bf16*)(ws + WS_MIXRAW), (float*)(ws + WS_SSQA), b, h, qb, mb); }
        split_wait(s2cnt, (unsigned)G * (unsigned)(rep + 1));
        for (int it = bx; it < 256; it += G) { const int qb = it & 7, hp = (it >> 3) & 3, b = it >> 5; ssd_item(lds, a, b, hp, qb); }
    GRID_BAR();
    }
    { pg8::Gemm g{(const bf16*)(ws + WS_MIXRAW), (const bf16*)(ws + WS_WOUT), T_, D_, D_, D_}; pg8::StaticOrder S; S.init(T_, D_, G, bx);
      LAS float* fac = (LAS float*)(lds + 128 * 1024);
      { const float* ssqa = (const float*)(ws + WS_SSQA); const float* ssqy = (const float*)(ws + WS_SSQY); pg8::Unit uu;
        if (threadIdx.x < 4) ((LAS int*)(fac + 4 * 768))[threadIdx.x] = -1;
        __syncthreads();
        for (int i = 0, nsl = 0, lastpm = -1; i < 16 && S.next(i, uu); ++i) { if (uu.pm == lastpm || nsl >= 4) continue; lastpm = uu.pm;
            if (threadIdx.x < 256) { const int row = uu.pm * 256 + threadIdx.x;
                const float sa = 1.0f / sqrtf(ssqa[row] * (1.0f / 512.0f) + EPS), s0 = 1.0f / sqrtf(ssqy[2 * row] * (1.0f / 256.0f) + EPS), s1 = 1.0f / sqrtf(ssqy[2 * row + 1] * (1.0f / 256.0f) + EPS);
                fac[nsl * 768 + threadIdx.x] = sa / s0; fac[nsl * 768 + 256 + threadIdx.x] = s0 / s1; fac[nsl * 768 + 512 + threadIdx.x] = s1; }
            if (threadIdx.x == 0) ((LAS int*)(fac + 4 * 768))[nsl] = uu.pm;
            ++nsl; }
        __syncthreads(); }
      pg8::EpiResidMix E{a.x, D_, (bf16*)(ws + WS_X1B), (float*)(ws + WS_SSQ), fac};
      pg8::gemm_phase<pg8::EpiResidMix, pg8::StaticOrder, true, true>(lds, g, S, E); }
    GRID_BAR();
    { pg8::Gemm g{(const bf16*)(ws + WS_X1B), (const bf16*)(ws + WS_WUP), T_, FF, D_, D_}; pg8::StaticOrder S; S.init(T_, FF, G, bx);
      pg8::EpiBf16<1> E{(bf16*)(ws + WS_U), FF, (float*)(ws + WS_SSQ)};
      pg8::gemm_phase<pg8::EpiBf16<1>, pg8::StaticOrder, true, true>(lds, g, S, E); }
    GRID_BAR();
    { pg8::Gemm g{(const bf16*)(ws + WS_U), (const bf16*)(ws + WS_WDN), T_, D_, FF, FF}; pg8::StaticOrder S; S.init(T_, D_, G, bx);
      pg8::EpiResid<false> E{nullptr, a.out, D_, (bf16*)(ws + WS_X1B), nullptr};
      pg8::gemm_phase<pg8::EpiResid<false>, pg8::StaticOrder, true, true>(lds, g, S, E); }
}

extern "C" void kernel_launch(void* const* d_in, const int* in_sizes, int n_in, void* d_out, int out_size, void* d_ws, size_t ws_size, hipStream_t stream) {
    static int grid = 0;
    if (grid == 0) {
        int dev = 0, cus = 0, per_cu = 0;
        hipGetDevice(&dev);
        hipDeviceGetAttribute(&cus, hipDeviceAttributeMultiprocessorCount, dev);
        if (hipFuncSetAttribute((const void*)fwd_megakernel, hipFuncAttributeMaxDynamicSharedMemorySize, LDS_BYTES) != hipSuccess) fprintf(stderr, "hipFuncSetAttribute failed\n");
        if (hipOccupancyMaxActiveBlocksPerMultiprocessor(&per_cu, (const void*)fwd_megakernel, NTHREADS, LDS_BYTES) != hipSuccess || per_cu < 1) { fprintf(stderr, "occupancy query: %d\n", per_cu); per_cu = 1; }
        (void)hipGetLastError();
        grid = cus * (per_cu > 1 ? 1 : per_cu);
        if (ws_size < 256 * MB) fprintf(stderr, "workspace too small: %zu\n", ws_size);
    }
    Args a{};
    a.x = (const float*)d_in[0]; a.pos = (const int*)d_in[1]; a.ln_mix_g = (const float*)d_in[2]; a.w_in = (const float*)d_in[3]; a.q_a_g = (const float*)d_in[4]; a.w_uq = (const float*)d_in[5];
    a.kv_a_g = (const float*)d_in[6]; a.w_ukv = (const float*)d_in[7]; a.q_norm_g = (const float*)d_in[8]; a.k_norm_g = (const float*)d_in[9]; a.attn_out_g = (const float*)d_in[10];
    a.conv_w = (const float*)d_in[11]; a.conv_b = (const float*)d_in[12]; a.a_log_f = (const float*)d_in[13]; a.a_log_b = (const float*)d_in[14]; a.dt_bias_f = (const float*)d_in[15];
    a.dt_bias_b = (const float*)d_in[16]; a.d_skip = (const float*)d_in[17]; a.ssm_norm_g = (const float*)d_in[18]; a.w_out = (const float*)d_in[19]; a.ln_mlp_g = (const float*)d_in[20];
    a.w_up = (const float*)d_in[21]; a.w_dn = (const float*)d_in[22]; a.out = (float*)d_out; a.ws = (unsigned char*)d_ws;
    (void)hipMemsetAsync((char*)d_ws + WS_BAR, 0, (XCD_BAR_WORDS + 128) * 4, stream);
    void* args[] = {&a};
    hipError_t e = hipLaunchCooperativeKernel((const void*)fwd_megakernel, dim3(grid), dim3(NTHREADS), args, LDS_BYTES, stream);
    if (e != hipSuccess) fprintf(stderr, "cooperative launch failed: %s (grid %d)\n", hipGetErrorString(e), grid);
}
```

```cpp
#include <hip/hip_runtime.h>
#include <hip/hip_cooperative_groups.h>
#include <cstdio>
#include <cstdint>
namespace cg = cooperative_groups;
__device__ __forceinline__ int opaque_tid() { int t = threadIdx.x; asm volatile("" : "+v"(t)); return t; }

namespace pg8 {
#define PG8_LAS __attribute__((address_space(3)))
typedef unsigned short bf16_t;
typedef short bf16x8 __attribute__((ext_vector_type(8)));
typedef float f32x4 __attribute__((ext_vector_type(4)));
typedef unsigned u32x4 __attribute__((ext_vector_type(4)));
constexpr int BM = 256, BK = 64, HALF = 128, HTB = HALF * BK * 2  , STAGE_BYTES = 8 * HTB, NXCD = 8, WGM = 8;

__host__ __device__ __forceinline__ int lds_byte(int r, int c) { const int st = (r >> 4) * 2 + (c >> 5), rr = r & 15, cc = c & 31, ob = rr * 64 + cc * 2; return st * 1024 + (ob ^ (((ob >> 9) & 1) << 5)); }
__host__ __device__ __forceinline__ void stage_rc(int b, int& R, int& C) { const int st = b / 1024, sb = b % 1024, swz = sb ^ (((sb >> 9) & 1) << 5); R = (st >> 1) * 16 + swz / 64; C = (st & 1) * 32 + (swz % 64) / 2; }
__host__ __device__ __forceinline__ int perm32(int rho) { const int n = rho >> 4, i = rho & 15; return 8 * (i >> 2) + 4 * n + (i & 3); }

struct Unit { int pm, pn; };
struct Gemm { const bf16_t* A; const bf16_t* Bt; int M, N, K, lda; };

struct StaticOrder {
    int nM, nN, nwg, G, c;
    __host__ __device__ void init(int M, int N, int G_, int c_) { nM = M / BM; nN = N / BM; nwg = nM * nN; G = G_; c = c_; }
    __host__ __device__ bool next(int i, Unit& u) const {
        const long L = (long)i * G + c; if (L >= nwg) return false;
        int wgid = (int)L; { const int q = nwg / NXCD, r = nwg % NXCD, xcd = wgid % NXCD, off = wgid / NXCD; wgid = (xcd < r ? xcd * (q + 1) : r * (q + 1) + (xcd - r) * q) + off; }
        const int nig = WGM * nN, gid = wgid / nig, fm = gid * WGM, gsz = (nM - fm) < WGM ? (nM - fm) : WGM;
        u.pm = fm + ((wgid % nig) % gsz); u.pn = (wgid % nig) / gsz; return true;
    }
    __device__ __forceinline__ void a_ready(const Unit&) const {}
    __device__ __forceinline__ void done(const Unit&) const {}
};

__device__ __forceinline__ unsigned cvt_pk_bf16(float lo, float hi) { unsigned r; asm volatile("v_cvt_pk_bf16_f32 %0, %1, %2" : "=v"(r) : "v"(lo), "v"(hi)); return r; }
typedef float f32x2 __attribute__((ext_vector_type(2)));

template <int MODE> struct EpiBf16 {
    static constexpr bool PERM = true, AFTER_DRAIN = false, KHOOK = false;
    bf16_t* O; int ldc; float* side;
    __device__ __forceinline__ void operator()(const f32x4 (&acc)[2][2][4][2], const Unit& u, int wr, int wc, int fr, int fq) const {
        const int row0 = u.pm * BM + wr * 64 + fr; const int col0 = u.pn * BM + wc * 32 + 8 * fq;
        float rsv[2][4];
#pragma unroll
        for (int ai = 0; ai < 2; ++ai)
#pragma unroll
            for (int m = 0; m < 4; ++m) rsv[ai][m] = (MODE == 1) ? side[row0 + ai * HALF + m * 16] : 0.f;
#pragma unroll
        for (int ai = 0; ai < 2; ++ai)
#pragma unroll
            for (int m = 0; m < 4; ++m) { const int row = row0 + ai * HALF + m * 16; bf16_t* rowp = O + (size_t)row * ldc + col0;
                float rs = 1.f; if (MODE == 1) rs = 1.0f / sqrtf(rsv[ai][m] * (1.0f / 1024.0f) + 1e-6f);
#pragma unroll
                for (int bj = 0; bj < 2; ++bj) { f32x4 v0 = acc[ai][bj][m][0], v1 = acc[ai][bj][m][1];
                    if (MODE == 1) {
#pragma unroll
                        for (int e = 0; e < 4; ++e) { float a = v0[e] > 0.f ? v0[e] * rs : 0.f; v0[e] = a * a; float b = v1[e] > 0.f ? v1[e] * rs : 0.f; v1[e] = b * b; } }
                    if (MODE == 2) { if (u.pn == 7 && bj == 1 && wc == 1 && fq < 2) { float* sp = side + (size_t)row * 16 + 8 * fq; *(f32x4*)sp = v0; *(f32x4*)(sp + 4) = v1; } }
                    u32x4 w; w.x = cvt_pk_bf16(v0[0], v0[1]); w.y = cvt_pk_bf16(v0[2], v0[3]); w.z = cvt_pk_bf16(v1[0], v1[1]); w.w = cvt_pk_bf16(v1[2], v1[3]);
                    *(u32x4*)(rowp + bj * HALF) = w; } }
    }
};
template <bool STATS> struct EpiResid {
    static constexpr bool PERM = true, AFTER_DRAIN = false, KHOOK = false;
    const float* base; float* out; int ldc; bf16_t* xb; float* ssq;
    __device__ __forceinline__ void operator()(const f32x4 (&acc)[2][2][4][2], const Unit& u, int wr, int wc, int fr, int fq) const {
        const int row0 = u.pm * BM + wr * 64 + fr; const int col0 = u.pn * BM + wc * 32 + 8 * fq;
#pragma unroll
        for (int ai = 0; ai < 2; ++ai) {
            f32x4 b0[4][2], b1[4][2]; u32x4 wx[4][2];
#pragma unroll
            for (int m = 0; m < 4; ++m)
#pragma unroll
                for (int bj = 0; bj < 2; ++bj) { const size_t o = (size_t)(row0 + ai * HALF + m * 16) * ldc + col0 + bj * HALF;
                    if (STATS) { b0[m][bj] = *(const f32x4*)(base + o); b1[m][bj] = *(const f32x4*)(base + o + 4); } else wx[m][bj] = *(const u32x4*)(xb + o); }
#pragma unroll
            for (int m = 0; m < 4; ++m) { const int row = row0 + ai * HALF + m * 16; const size_t ro = (size_t)row * ldc + col0; float sq = 0.f;
#pragma unroll
                for (int bj = 0; bj < 2; ++bj) { const size_t o = ro + bj * HALF;
                    if (STATS) {
                        const f32x4 v0 = b0[m][bj] + acc[ai][bj][m][0], v1 = b1[m][bj] + acc[ai][bj][m][1];
                        u32x4 w; w.x = cvt_pk_bf16(v0[0], v0[1]); w.y = cvt_pk_bf16(v0[2], v0[3]); w.z = cvt_pk_bf16(v1[0], v1[1]); w.w = cvt_pk_bf16(v1[2], v1[3]); *(u32x4*)(xb + o) = w;
                        sq += (v0[0] * v0[0] + v0[1] * v0[1]) + (v0[2] * v0[2] + v0[3] * v0[3]) + (v1[0] * v1[0] + v1[1] * v1[1]) + (v1[2] * v1[2] + v1[3] * v1[3]);
                    } else {
                        const u32x4 w = wx[m][bj];
                        f32x4 c0, c1; c0[0] = __builtin_bit_cast(float, w.x << 16); c0[1] = __builtin_bit_cast(float, w.x & 0xffff0000u); c0[2] = __builtin_bit_cast(float, w.y << 16); c0[3] = __builtin_bit_cast(float, w.y & 0xffff0000u);
                        c1[0] = __builtin_bit_cast(float, w.z << 16); c1[1] = __builtin_bit_cast(float, w.z & 0xffff0000u); c1[2] = __builtin_bit_cast(float, w.w << 16); c1[3] = __builtin_bit_cast(float, w.w & 0xffff0000u);
                        *(f32x4*)(out + o) = c0 + acc[ai][bj][m][0]; *(f32x4*)(out + o + 4) = c1 + acc[ai][bj][m][1];
                    } }
                if (STATS) { sq += __shfl_xor(sq, 16); sq += __shfl_xor(sq, 32); if (fq == 0) atomicAdd(ssq + row, sq); } }
        }
    }
};

struct EpiResidMix {
    static constexpr bool PERM = true, AFTER_DRAIN = false, KHOOK = true;
    const float* base; int ldc; bf16_t* xb; float* ssq;
    const PG8_LAS float* fac;
    __device__ __forceinline__ int slot_of(const Unit& u) const { const PG8_LAS int* pms = (const PG8_LAS int*)(fac + 4 * 768); int sl = 0;
#pragma unroll
        for (int i = 1; i < 4; ++i) if (pms[i] == u.pm) sl = i;
        return sl; }
    __device__ __forceinline__ void khook(f32x4 (&acc)[2][2][4][2], const Unit& u, int t, int wr, int fr) const {
        const PG8_LAS float* f = fac + slot_of(u) * 768 + (t == 8 ? 0 : 256) + wr * 64 + fr;
#pragma unroll
        for (int ai = 0; ai < 2; ++ai)
#pragma unroll
            for (int m = 0; m < 4; ++m) { const float sc = f[ai * HALF + m * 16];
#pragma unroll
                for (int bj = 0; bj < 2; ++bj)
#pragma unroll
                    for (int n = 0; n < 2; ++n) acc[ai][bj][m][n] = acc[ai][bj][m][n] * sc; }
    }
    __device__ __forceinline__ void operator()(const f32x4 (&acc)[2][2][4][2], const Unit& u, int wr, int wc, int fr, int fq) const {
        const int row0 = u.pm * BM + wr * 64 + fr; const int col0 = u.pn * BM + wc * 32 + 8 * fq;
        const PG8_LAS float* f = fac + slot_of(u) * 768 + 512 + wr * 64 + fr;
#pragma unroll
        for (int ai = 0; ai < 2; ++ai) {
            f32x4 b0[4][2], b1[4][2]; float fs[4];
#pragma unroll
            for (int m = 0; m < 4; ++m) { fs[m] = f[ai * HALF + m * 16];
#pragma unroll
                for (int bj = 0; bj < 2; ++bj) { const size_t o = (size_t)(row0 + ai * HALF + m * 16) * ldc + col0 + bj * HALF; b0[m][bj] = *(const f32x4*)(base + o); b1[m][bj] = *(const f32x4*)(base + o + 4); } }
#pragma unroll
            for (int m = 0; m < 4; ++m) { const int row = row0 + ai * HALF + m * 16; const size_t ro = (size_t)row * ldc + col0; float sq = 0.f;
#pragma unroll
                for (int bj = 0; bj < 2; ++bj) { const size_t o = ro + bj * HALF;
                    const f32x4 v0 = b0[m][bj] + acc[ai][bj][m][0] * fs[m], v1 = b1[m][bj] + acc[ai][bj][m][1] * fs[m];
                    u32x4 w; w.x = cvt_pk_bf16(v0[0], v0[1]); w.y = cvt_pk_bf16(v0[2], v0[3]); w.z = cvt_pk_bf16(v1[0], v1[1]); w.w = cvt_pk_bf16(v1[2], v1[3]); *(u32x4*)(xb + o) = w;
                    sq += (v0[0] * v0[0] + v0[1] * v0[1]) + (v0[2] * v0[2] + v0[3] * v0[3]) + (v1[0] * v1[0] + v1[1] * v1[1]) + (v1[2] * v1[2] + v1[3] * v1[3]); }
                sq += __shfl_xor(sq, 16); sq += __shfl_xor(sq, 32); if (fq == 0) atomicAdd(ssq + row, sq); }
        }
    }
};

template <class Epi, class Sched, bool ALIGN_EPI = false, bool SP2 = false>
__device__ __forceinline__ void gemm_phase(PG8_LAS unsigned char* lds, const Gemm g, const Sched& S, const Epi& E) {
    const int tid = opaque_tid(), wid = __builtin_amdgcn_readfirstlane(tid >> 6), lane = tid & 63, wr = wid >> 2, wc = wid & 3, fr = lane & 15, fq = lane >> 4;
    int K = g.K; asm volatile("" : "+s"(K));
    const int nt = K / BK;
    unsigned voffA[2], voffB[2];
#pragma unroll
    for (int i = 0; i < 2; ++i) { int R, C; stage_rc(tid * 16 + i * 8192, R, C); const int Rb = Epi::PERM ? ((R & ~31) + perm32(R & 31)) : R;
        voffA[i] = (unsigned)(R * g.lda + C) * 2u; voffB[i] = (unsigned)(Rb * K + C) * 2u; }
    const size_t kstep = (size_t)(BK * 2);
    const size_t hstepB = (size_t)HALF * K * 2, hstepA = (size_t)HALF * g.lda * 2;
    const size_t tstepB = 2 * hstepB, tstepA = 2 * hstepA;
    const unsigned ldsw = (unsigned)wid * 1024u;
    const int aoff = lds_byte(wr * 64 + fr, fq * 8), boff = lds_byte(wc * 32 + fr, fq * 8);
#define PG8_SA(b, h) (((b) * 2 + (h)) * HTB)
#define PG8_SB(b, h) ((4 + (b) * 2 + (h)) * HTB)
#define PG8_STAGE(bufoff, gbase, voff) do { _Pragma("unroll") for (int _i = 0; _i < 2; ++_i) \
        __builtin_amdgcn_global_load_lds((const unsigned*)((const char*)(gbase) + (voff)[_i]), (PG8_LAS unsigned*)(lds + (bufoff) + ldsw + _i * 8192), 16, 0, 0); } while (0)
#define PG8_LDA(dst, b, h) do { _Pragma("unroll") for (int m = 0; m < 4; ++m) _Pragma("unroll") for (int k = 0; k < 2; ++k) dst[m][k] = *(const PG8_LAS bf16x8*)(lds + PG8_SA(b, h) + aoff + m * 2048 + k * 1024); } while (0)
#define PG8_LDB(dst, b, h) do { _Pragma("unroll") for (int n = 0; n < 2; ++n) _Pragma("unroll") for (int k = 0; k < 2; ++k) dst[n][k] = *(const PG8_LAS bf16x8*)(lds + PG8_SB(b, h) + boff + n * 2048 + k * 1024); } while (0)
#define PG8_MMA(ai, bj, At, Bt) do { __builtin_amdgcn_s_setprio(1); _Pragma("unroll") for (int m = 0; m < 4; ++m) _Pragma("unroll") for (int n = 0; n < 2; ++n) _Pragma("unroll") for (int k = 0; k < 2; ++k) \
        acc[ai][bj][m][n] = __builtin_amdgcn_mfma_f32_16x16x32_bf16(Bt[n][k], At[m][k], acc[ai][bj][m][n], 0, 0, 0); __builtin_amdgcn_s_setprio(0); } while (0)
#define PG8_WAIT_V(n) asm volatile("s_waitcnt vmcnt(" #n ")" ::: "memory")
#define PG8_WAIT_L(n) asm volatile("s_waitcnt lgkmcnt(" #n ")" ::: "memory")
#define PG8_BAR __builtin_amdgcn_s_barrier()
#define PG8_SCHED __builtin_amdgcn_sched_barrier(0)
    Unit cur, nxt; int ui = 0;
    if (!S.next(0, cur)) return;
    f32x4 acc[2][2][4][2];
#pragma unroll
    for (int a = 0; a < 2; ++a)
#pragma unroll
        for (int b = 0; b < 2; ++b)
#pragma unroll
            for (int m = 0; m < 4; ++m)
#pragma unroll
                for (int n = 0; n < 2; ++n) acc[a][b][m][n] = (f32x4){0.f, 0.f, 0.f, 0.f};
    bf16x8 At[4][2], B0[2][2], B1[2][2];
    const char* cA = (const char*)g.A + (size_t)cur.pm * tstepA; const char* cB = (const char*)g.Bt + (size_t)cur.pn * tstepB;
    S.a_ready(cur);
    if constexpr (SP2) {
        PG8_STAGE(PG8_SB(0, 0), cB, voffB); PG8_STAGE(PG8_SB(0, 1), cB + hstepB, voffB); PG8_STAGE(PG8_SA(0, 0), cA, voffA); PG8_STAGE(PG8_SA(0, 1), cA + hstepA, voffA);
        if (wr == 1) PG8_BAR;
        PG8_WAIT_V(2); PG8_BAR;
        PG8_STAGE(PG8_SB(1, 0), cB + kstep, voffB); PG8_STAGE(PG8_SA(1, 0), cA + kstep, voffA); PG8_STAGE(PG8_SB(1, 1), cB + hstepB + kstep, voffB);
        PG8_WAIT_V(6); PG8_BAR;
    } else {
        PG8_STAGE(PG8_SB(0, 0), cB, voffB); PG8_STAGE(PG8_SA(0, 0), cA, voffA); PG8_STAGE(PG8_SB(0, 1), cB + hstepB, voffB); PG8_STAGE(PG8_SA(0, 1), cA + hstepA, voffA);
        if (wr == 1) PG8_BAR;
        PG8_WAIT_V(4); PG8_BAR;
        PG8_STAGE(PG8_SB(1, 0), cB + kstep, voffB); PG8_STAGE(PG8_SA(1, 0), cA + kstep, voffA); PG8_STAGE(PG8_SB(1, 1), cB + hstepB + kstep, voffB);
        PG8_WAIT_V(6); PG8_BAR;
    }
    for (;;) {
        const bool has_next = S.next(ui + 1, nxt);
        const char* nA = has_next ? (const char*)g.A + (size_t)nxt.pm * tstepA : cA; const char* nB = has_next ? (const char*)g.Bt + (size_t)nxt.pn * tstepB : cB;
        for (int t = 0; t < nt; t += 2) {
            if constexpr (Epi::KHOOK) { if (t == 8 || t == 12) E.khook(acc, cur, t, wr, fr); }
            const bool last = (t == nt - 2);
            const char* a1 = cA + (size_t)(t + 1) * kstep;
            const char* a2 = last ? nA : cA + (size_t)(t + 2) * kstep; const char* b2 = last ? nB : cB + (size_t)(t + 2) * kstep;
            const char* a3 = a2 + kstep; const char* b3 = b2 + kstep;
            if (last && has_next) S.a_ready(nxt);
            if constexpr (SP2) {
            PG8_LDB(B0, 0, 0); PG8_LDB(B1, 0, 1); PG8_SCHED; PG8_LDA(At, 0, 0); PG8_STAGE(PG8_SA(1, 1), a1 + hstepA, voffA);
            PG8_WAIT_V(8); PG8_WAIT_L(0); PG8_BAR; PG8_MMA(0, 0, At, B0); PG8_MMA(0, 1, At, B1); PG8_BAR; PG8_SCHED;
            PG8_LDA(At, 0, 1); PG8_STAGE(PG8_SB(0, 0), b2, voffB); PG8_STAGE(PG8_SB(0, 1), b2 + hstepB, voffB); PG8_STAGE(PG8_SA(0, 0), a2, voffA);
            PG8_WAIT_V(8); PG8_WAIT_L(0); PG8_BAR; PG8_MMA(1, 0, At, B0); PG8_MMA(1, 1, At, B1); PG8_BAR; PG8_SCHED;
            PG8_LDB(B0, 1, 0); PG8_LDB(B1, 1, 1); PG8_SCHED; PG8_LDA(At, 1, 0); PG8_STAGE(PG8_SA(0, 1), a2 + hstepA, voffA);
            PG8_WAIT_V(8); PG8_WAIT_L(0); PG8_BAR; PG8_MMA(0, 0, At, B0); PG8_MMA(0, 1, At, B1); PG8_BAR; PG8_SCHED;
            PG8_LDA(At, 1, 1); PG8_STAGE(PG8_SB(1, 0), b3, voffB); PG8_STAGE(PG8_SB(1, 1), b3 + hstepB, voffB); PG8_STAGE(PG8_SA(1, 0), a3, voffA);
            PG8_WAIT_V(8); PG8_WAIT_L(0); PG8_BAR; PG8_MMA(1, 0, At, B0); PG8_MMA(1, 1, At, B1); PG8_BAR; PG8_SCHED;
            } else {
            PG8_LDB(B0, 0, 0); PG8_SCHED; PG8_LDA(At, 0, 0); PG8_STAGE(PG8_SA(1, 1), a1 + hstepA, voffA);
            PG8_WAIT_L(8); PG8_BAR; PG8_WAIT_L(0); PG8_MMA(0, 0, At, B0); PG8_BAR; PG8_SCHED;
            PG8_LDB(B1, 0, 1); PG8_STAGE(PG8_SB(0, 0), b2, voffB);
            PG8_BAR; PG8_WAIT_L(0); PG8_MMA(0, 1, At, B1); PG8_BAR;
            PG8_LDA(At, 0, 1); PG8_STAGE(PG8_SA(0, 0), a2, voffA);
            PG8_BAR; PG8_WAIT_L(0); PG8_MMA(1, 0, At, B0); PG8_BAR; PG8_SCHED;
            PG8_STAGE(PG8_SB(0, 1), b2 + hstepB, voffB);
            PG8_WAIT_V(6); PG8_BAR; PG8_MMA(1, 1, At, B1); PG8_BAR;
            PG8_LDB(B0, 1, 0); PG8_SCHED; PG8_LDA(At, 1, 0); PG8_STAGE(PG8_SA(0, 1), a2 + hstepA, voffA);
            PG8_WAIT_L(8); PG8_BAR; PG8_WAIT_L(0); PG8_MMA(0, 0, At, B0); PG8_BAR; PG8_SCHED;
            PG8_LDB(B1, 1, 1); PG8_STAGE(PG8_SB(1, 0), b3, voffB);
            PG8_BAR; PG8_WAIT_L(0); PG8_MMA(0, 1, At, B1); PG8_BAR;
            PG8_LDA(At, 1, 1); PG8_STAGE(PG8_SA(1, 0), a3, voffA);
            PG8_BAR; PG8_WAIT_L(0); PG8_MMA(1, 0, At, B0); PG8_BAR; PG8_SCHED;
            PG8_STAGE(PG8_SB(1, 1), b3 + hstepB, voffB);
            PG8_WAIT_V(6); PG8_BAR; PG8_MMA(1, 1, At, B1); PG8_BAR;
            }
        }
        if constexpr (ALIGN_EPI) { if (wr == 0) PG8_BAR; }
        if constexpr (!Epi::AFTER_DRAIN) { E(acc, cur, wr, wc, fr, fq); S.done(cur); }
        if (!has_next) break;
#pragma unroll
        for (int a = 0; a < 2; ++a)
#pragma unroll
            for (int b = 0; b < 2; ++b)
#pragma unroll
                for (int m = 0; m < 4; ++m)
#pragma unroll
                    for (int n = 0; n < 2; ++n) acc[a][b][m][n] = (f32x4){0.f, 0.f, 0.f, 0.f};
        cur = nxt; cA = nA; cB = nB; ++ui;
        if constexpr (ALIGN_EPI) { if (wr == 1) PG8_BAR; }
    }
    PG8_WAIT_V(0);
    if constexpr (!ALIGN_EPI) { if (wr == 0) PG8_BAR; }
    PG8_BAR;
    if constexpr (Epi::AFTER_DRAIN) { E.fused(acc, cur, wr, wc, fr, fq, lds, wid, lane); S.done(cur); }
#undef PG8_SA
#undef PG8_SB
#undef PG8_STAGE
#undef PG8_LDA
#undef PG8_LDB
#undef PG8_MMA
#undef PG8_WAIT_V
#undef PG8_WAIT_L
#undef PG8_BAR
#undef PG8_SCHED
}
}
#define LAS __attribute__((address_space(3)))
typedef unsigned short bf16;
typedef float f32x4 __attribute__((ext_vector_type(4)));
typedef float f32x2 __attribute__((ext_vector_type(2)));
typedef float f32x16 __attribute__((ext_vector_type(16)));
typedef short bf16x8 __attribute__((ext_vector_type(8)));
typedef short s16x4 __attribute__((ext_vector_type(4)));
typedef unsigned u32x4 __attribute__((ext_vector_type(4)));
typedef unsigned u32x2 __attribute__((ext_vector_type(2)));
typedef __bf16 bf16x2_t __attribute__((ext_vector_type(2)));
#define MFMA32(a, b, c) __builtin_amdgcn_mfma_f32_32x32x16_bf16((a), (b), (c), 0, 0, 0)

constexpr int NB = 8, S_ = 2048, T_ = NB * S_, D_ = 1024, NPROJ = 2048, INW = 1968, FF = 4096;
constexpr int NWAVES = 8, NTHREADS = 512;
constexpr int LDS_BYTES = 144 * 1024;
constexpr float EPS = 1e-6f;
constexpr float LOG2E = 1.4426950408889634f;
constexpr int C_CQ = 0, C_CKV = 256, C_KPE = 384, C_Z = 416, C_XBC = 928, C_DT = 1952;
constexpr size_t MB = 1024 * 1024;
constexpr size_t WS_PROJ = 0, WS_QRAW = 64 * MB, WS_KVRAW = 88 * MB, WS_VEC = 120 * MB, WS_DTRAW = 124 * MB;
constexpr size_t WS_ATTNO = 64 * MB, WS_YG = 88 * MB, WS_U = 0;
constexpr size_t WS_HB = 128 * MB;
constexpr size_t WS_BT = WS_HB + 24 * MB;
constexpr size_t HST_OFF = (size_t)8 * 1024 * 1024;
constexpr size_t WS_K = 160 * MB, WS_VT = 184 * MB, WS_BM = 200 * MB, WS_CM = 208 * MB, WS_XT = 216 * MB;
constexpr size_t WS_WIN = 232 * MB, WS_WUQ = 236 * MB, WS_WUKV = WS_WUQ + 768 * 256 * 2, WS_WOUT = WS_WUKV + 1024 * 128 * 2, WS_WUP = WS_WOUT + 2 * MB, WS_WDN = WS_WUP + 8 * MB;
constexpr size_t WS_MIXRAW = 64 * MB;
constexpr size_t WS_SSQA = 255 * MB + 64 * 1024, WS_SSQY = 255 * MB + 128 * 1024;
constexpr size_t WS_BAR = 255 * MB + 256 * 1024;
constexpr int MISC_OFF = 140 * 1024;
constexpr size_t WS_SSQ = 255 * MB, WS_X1B = WS_K;
static_assert(WS_WDN + 8 * MB <= WS_SSQ, "ws map");

struct Args {
    const float* x; const int* pos; const float* ln_mix_g; const float* w_in; const float* q_a_g; const float* w_uq; const float* kv_a_g; const float* w_ukv;
    const float* q_norm_g; const float* k_norm_g; const float* attn_out_g; const float* conv_w; const float* conv_b; const float* a_log_f; const float* a_log_b;
    const float* dt_bias_f; const float* dt_bias_b; const float* d_skip; const float* ssm_norm_g; const float* w_out; const float* ln_mlp_g; const float* w_up; const float* w_dn;
    float* out; unsigned char* ws;
};

__device__ __forceinline__ unsigned f2bf(float f) { unsigned u = __builtin_bit_cast(unsigned, f); return (u + 0x7fffu + ((u >> 16) & 1u)) >> 16; }
__device__ __forceinline__ unsigned pk2(float lo, float hi) { f32x2 v = {lo, hi}; bf16x2_t b = __builtin_convertvector(v, bf16x2_t); return __builtin_bit_cast(unsigned, b); }
__device__ __forceinline__ float bf2f(unsigned short b) { return __builtin_bit_cast(float, (unsigned)b << 16); }
__device__ __forceinline__ float bflo(unsigned w) { return __builtin_bit_cast(float, w << 16); }
__device__ __forceinline__ float bfhi(unsigned w) { return __builtin_bit_cast(float, w & 0xffff0000u); }
__device__ __forceinline__ float wave_sum(float v) {
#pragma unroll
    for (int o = 1; o < 64; o <<= 1) v += __shfl_xor(v, o);
    return v;
}
__device__ __forceinline__ float ex2(float x) { return __builtin_amdgcn_exp2f(x); }
__device__ __forceinline__ float silu(float z) { return z / (1.f + __expf(-z)); }

__device__ __forceinline__ void transpose_item(const float* W, int K, int N, bf16* WT, const float* gain, LAS float* scr, int item, int nblk, int lane) {
    const int kb = item / nblk, nb = item % nblk, k0 = 64 * kb, n0 = 64 * nb;
    const int kr = lane >> 4, nc = 4 * (lane & 15);
    const bool ok = (n0 + nc) < N;
    f32x4 v[16];
#pragma unroll
    for (int i = 0; i < 16; ++i) { v[i] = (f32x4){0.f, 0.f, 0.f, 0.f}; if (ok) v[i] = *(const f32x4*)(W + (size_t)(k0 + 4 * i + kr) * N + n0 + nc); }
    if (gain) {
#pragma unroll
        for (int i = 0; i < 16; ++i) v[i] = v[i] * gain[k0 + 4 * i + kr]; }
#pragma unroll
    for (int i = 0; i < 16; ++i) { LAS float* d = scr + (4 * i + kr) * 65 + nc; d[0] = v[i].x; d[1] = v[i].y; d[2] = v[i].z; d[3] = v[i].w; }
    asm volatile("s_waitcnt lgkmcnt(0)" ::: "memory");
    const int c = lane & 7;
#pragma unroll
    for (int j = 0; j < 8; ++j) { const int n = (lane >> 3) + 8 * j; const LAS float* sp = scr + (8 * c) * 65 + n;
        u32x4 o; o.x = pk2(sp[0 * 65], sp[1 * 65]); o.y = pk2(sp[2 * 65], sp[3 * 65]); o.z = pk2(sp[4 * 65], sp[5 * 65]); o.w = pk2(sp[6 * 65], sp[7 * 65]);
        *(u32x4*)(WT + (size_t)(n0 + n) * K + k0 + 8 * c) = o; }
    asm volatile("s_waitcnt lgkmcnt(0)" ::: "memory");
}
__device__ __forceinline__ void rms_row_to_bf16(const float* xrow, const float* g, bf16* orow, int lane) {
    const f32x4* xr = (const f32x4*)xrow + lane; const f32x4* gr = (const f32x4*)g + lane;
    f32x4 v[4]; float s = 0.f;
#pragma unroll
    for (int j = 0; j < 4; ++j) { v[j] = xr[64 * j]; s += (v[j].x * v[j].x + v[j].y * v[j].y) + (v[j].z * v[j].z + v[j].w * v[j].w); }
    const float rstd = 1.f / sqrtf(wave_sum(s) * (1.f / D_) + EPS);
    u32x2* o8 = (u32x2*)orow + lane;
#pragma unroll
    for (int j = 0; j < 4; ++j) { const f32x4 gg = gr[64 * j]; u32x2 o; o.x = pk2(v[j].x * rstd * gg.x, v[j].y * rstd * gg.y); o.y = pk2(v[j].z * rstd * gg.z, v[j].w * rstd * gg.w); o8[64 * j] = o; }
}
__device__ __forceinline__ void p0_prologue(const Args& a, LAS unsigned char* lds) {
    const int tid = opaque_tid(), lane = tid & 63, wave = tid >> 6;
    LAS float* scr = (LAS float*)(lds + wave * 16640);
    const int gw = blockIdx.x * NWAVES + wave, NGW = gridDim.x * NWAVES;
    constexpr int I_IN = (D_ / 64) * (NPROJ / 64), I_UQ = (256 / 64) * (768 / 64), I_UKV = (128 / 64) * (1024 / 64), I_OUT = (D_ / 64) * (D_ / 64), I_UP = (D_ / 64) * (FF / 64), I_DN = (FF / 64) * (D_ / 64);
    constexpr int NITEMS = I_IN + I_UQ + I_UKV + I_OUT + I_UP + I_DN;
    unsigned char* ws = a.ws;
    for (int it = gw; it < I_IN + I_UQ + I_UKV + I_OUT; it += NGW) {
        int r = it;
        if (r < I_IN) { transpose_item(a.w_in, D_, INW, (bf16*)(ws + WS_WIN), nullptr, scr, r, NPROJ / 64, lane); continue; } r -= I_IN;
        if (r < I_UQ) { transpose_item(a.w_uq, 256, 768, (bf16*)(ws + WS_WUQ), a.q_a_g, scr, r, 768 / 64, lane); continue; } r -= I_UQ;
        if (r < I_UKV) { transpose_item(a.w_ukv, 128, 1024, (bf16*)(ws + WS_WUKV), a.kv_a_g, scr, r, 1024 / 64, lane); continue; } r -= I_UKV;
        if (r < I_OUT) { transpose_item(a.w_out, D_, D_, (bf16*)(ws + WS_WOUT), (64 * (r / (D_ / 64)) < 512) ? a.attn_out_g : a.ssm_norm_g - 512, scr, r, D_ / 64, lane); continue; } r -= I_OUT;
    }
    bf16* H = (bf16*)(ws + WS_HB);
    for (int m = gw; m < T_; m += NGW) rms_row_to_bf16(a.x + (size_t)m * D_, a.ln_mix_g, H + (size_t)m * D_, lane);
    { float* ssq = (float*)(ws + WS_SSQ); float* sa = (float*)(ws + WS_SSQA); float* sy = (float*)(ws + WS_SSQY);
      for (int i = blockIdx.x * NTHREADS + tid; i < T_; i += gridDim.x * NTHREADS) { ssq[i] = 0.f; sa[i] = 0.f; sy[2 * i] = 0.f; sy[2 * i + 1] = 0.f; } }
}

__device__ __forceinline__ void p0b_mlp_weights(const Args& a, LAS unsigned char* lds) {
    const int tid = opaque_tid(), lane = tid & 63, wave = tid >> 6;
    LAS float* scr = (LAS float*)(lds + wave * 16640);
    const int gw = blockIdx.x * NWAVES + wave, NGW = gridDim.x * NWAVES;
    constexpr int I_UP = (D_ / 64) * (FF / 64), I_DN = (FF / 64) * (D_ / 64);
    for (int it = gw; it < I_UP + I_DN; it += NGW) {
        if (it < I_UP) transpose_item(a.w_up, D_, FF, (bf16*)(a.ws + WS_WUP), a.ln_mlp_g, scr, it, FF / 64, lane);
        else transpose_item(a.w_dn, FF, D_, (bf16*)(a.ws + WS_WDN), nullptr, scr, it - I_UP, D_ / 64, lane);
    }
    __syncthreads();
}

__device__ __forceinline__ void prep_conv(const Args& a, LAS unsigned char* lds) {
    const int tid = opaque_tid(), cg8 = tid & 63, tq = tid >> 6;
    const bf16* proj = (const bf16*)(a.ws + WS_PROJ);
    bf16* Xt = (bf16*)(a.ws + WS_XT); bf16* Bm = (bf16*)(a.ws + WS_BM); bf16* Cm = (bf16*)(a.ws + WS_CM); bf16* Btr = (bf16*)(a.ws + WS_BT);
    LAS bf16* tile = (LAS bf16*)lds;
    for (int item = blockIdx.x; item < NB * 32 * 2; item += gridDim.x) {
        const int half = item & 1, tb = (item >> 1) & 31, b = item >> 6;
        const int ch = half * 512 + cg8 * 8, t0 = tb * 64 + tq * 8;
        u32x4 rows[12];
#pragma unroll
        for (int k = 0; k < 12; ++k) { const int tt = t0 - 2 + k; rows[k] = (u32x4){0u, 0u, 0u, 0u}; if (tt >= 0 && tt < S_) rows[k] = *(const u32x4*)(proj + (size_t)(b * S_ + tt) * NPROJ + C_XBC + ch); }
        f32x2 w2[5][4], b2[4];
#pragma unroll
        for (int j = 0; j < 5; ++j) { const f32x4 w0 = *(const f32x4*)(a.conv_w + j * 1024 + ch), w1 = *(const f32x4*)(a.conv_w + j * 1024 + ch + 4);
            w2[j][0] = (f32x2){w0.x, w0.y}; w2[j][1] = (f32x2){w0.z, w0.w}; w2[j][2] = (f32x2){w1.x, w1.y}; w2[j][3] = (f32x2){w1.z, w1.w}; }
        { const f32x4 b0 = *(const f32x4*)(a.conv_b + ch), b1 = *(const f32x4*)(a.conv_b + ch + 4);
          b2[0] = (f32x2){b0.x, b0.y}; b2[1] = (f32x2){b0.z, b0.w}; b2[2] = (f32x2){b1.x, b1.y}; b2[3] = (f32x2){b1.z, b1.w}; }
        f32x2 xr[12][4];
#pragma unroll
        for (int k = 0; k < 12; ++k) { const u32x4 v = rows[k]; xr[k][0] = (f32x2){bflo(v.x), bfhi(v.x)}; xr[k][1] = (f32x2){bflo(v.y), bfhi(v.y)}; xr[k][2] = (f32x2){bflo(v.z), bfhi(v.z)}; xr[k][3] = (f32x2){bflo(v.w), bfhi(v.w)}; }
        __syncthreads();
#pragma unroll
        for (int i = 0; i < 8; ++i) {
            f32x2 o2[4];
#pragma unroll
            for (int q = 0; q < 4; ++q) o2[q] = b2[q];
#pragma unroll
            for (int j = 0; j < 5; ++j) { o2[0] += w2[j][0] * xr[i + j][0]; o2[1] += w2[j][1] * xr[i + j][1]; o2[2] += w2[j][2] * xr[i + j][2]; o2[3] += w2[j][3] * xr[i + j][3]; }
            unsigned pw[4];
#pragma unroll
            for (int q = 0; q < 4; ++q) { const f32x2 tneg = o2[q] * (-LOG2E); f32x2 d; d.x = __builtin_amdgcn_exp2f(tneg.x); d.y = __builtin_amdgcn_exp2f(tneg.y); d = d + 1.0f;
                f32x2 rc; rc.x = __builtin_amdgcn_rcpf(d.x); rc.y = __builtin_amdgcn_rcpf(d.y); const f32x2 res = o2[q] * rc; pw[q] = pk2(res.x, res.y); }
            if (half == 0) {
#pragma unroll
                for (int q = 0; q < 4; ++q) { tile[(cg8 * 8 + 2 * q) * 66 + tq * 8 + i] = (bf16)(pw[q] & 0xffffu); tile[(cg8 * 8 + 2 * q + 1) * 66 + tq * 8 + i] = (bf16)(pw[q] >> 16); }
            } else {
                const int k = cg8 >> 4, isC = k >> 1, g = k & 1, n = (cg8 & 15) * 8;
                bf16* dst = (isC ? Cm : Bm) + ((size_t)(b * 2 + g) * S_ + t0 + i) * 128 + n;
                *(u32x4*)dst = (u32x4){pw[0], pw[1], pw[2], pw[3]};
                if (cg8 < 32) {
#pragma unroll
                    for (int q = 0; q < 4; ++q) { tile[(cg8 * 8 + 2 * q) * 66 + tq * 8 + i] = (bf16)(pw[q] & 0xffffu); tile[(cg8 * 8 + 2 * q + 1) * 66 + tq * 8 + i] = (bf16)(pw[q] >> 16); } }
            }
        }
        __syncthreads();
        {
            const int c8 = tid & 7;
#pragma unroll
            for (int k = 0; k < 8; ++k) { const int row = (tid >> 3) + 64 * k;
                if (half == 0 || k < 4) {
                    const LAS unsigned* src = (const LAS unsigned*)(tile + row * 66 + c8 * 8);
                    u32x4 o; o.x = src[0]; o.y = src[1]; o.z = src[2]; o.w = src[3];
                    bf16* dst = (half == 0 ? Xt + ((size_t)b * 512 + row) * S_ : Btr + ((size_t)b * 256 + row) * S_) + tb * 64 + 8 * c8;
                    *(u32x4*)dst = o; } }
        }
    }
    __syncthreads();
}
__device__ __forceinline__ float softplus(float v) { return v > 20.f ? v : log1pf(__expf(v)); }
__device__ __forceinline__ void prep_scan(const Args& a, LAS unsigned char* lds) {
    const int tid = opaque_tid(), lane = tid & 63, wave = tid >> 6;
    const float* dtraw = (const float*)(a.ws + WS_DTRAW);
    float* vec = (float*)(a.ws + WS_VEC);
    const size_t VS = (size_t)NB * 8 * S_;
    LAS float* red = (LAS float*)lds;
    for (int item = (int)gridDim.x - 1 - (int)blockIdx.x; item < NB * 8; item += gridDim.x) {
        const int b = item >> 3, hd = item & 7;
        float* vb = vec + ((size_t)b * 8 + hd) * S_;
        const float af_c = -__expf(a.a_log_f[hd]) * LOG2E, ab_c = -__expf(a.a_log_b[hd]) * LOG2E;
        const float bf_ = a.dt_bias_f[hd], bb_ = a.dt_bias_b[hd];
        const int t0 = tid * 4;
        float dtf[4], dtb[4], pf[4], pb[4]; float sf = 0.f, sb = 0.f;
#pragma unroll
        for (int i = 0; i < 4; ++i) { const float* p = dtraw + (size_t)(b * S_ + t0 + i) * 16; dtf[i] = softplus(p[hd] + bf_); dtb[i] = softplus(p[8 + hd] + bb_); }
#pragma unroll
        for (int i = 0; i < 4; ++i) { pb[i] = sb; sf += dtf[i] * af_c; sb += dtb[i] * ab_c; pf[i] = sf; }
        float incf = sf, incb = sb;
#pragma unroll
        for (int o = 1; o < 64; o <<= 1) { const float uf = __shfl_up(incf, o), ub = __shfl_up(incb, o); if (lane >= o) { incf += uf; incb += ub; } }
        __syncthreads();
        if (lane == 63) { red[wave] = incf; red[8 + wave] = incb; }
        __syncthreads();
        float offf = 0.f, offb = 0.f, TOTB = 0.f;
#pragma unroll
        for (int w2 = 0; w2 < 8; ++w2) { const float vf = red[w2], vbb = red[8 + w2]; if (w2 < wave) { offf += vf; offb += vbb; } TOTB += vbb; }
        incf += offf; incb += offb;
        const float afK0 = __shfl(incf, lane | 15);
        const float rbK0 = TOTB - __shfl(incb - sb, lane & ~15);
        const float afK1 = __shfl(incf, 63);
        const float rbK1 = TOTB - __shfl(incb - sb, 0);
        const float basef = incf - sf, baseb = incb - sb;
        f32x4 o_af, o_rb, o_vtf, o_vtb, o_dtf, o_dtb, o_wf, o_wb;
#pragma unroll
        for (int i = 0; i < 4; ++i) { const float af = basef + pf[i], rb = TOTB - (baseb + pb[i]);
            o_af[i] = af; o_rb[i] = rb; o_vtf[i] = ex2(afK0 - af) * dtf[i]; o_vtb[i] = ex2(rbK0 - rb) * dtb[i]; o_dtf[i] = dtf[i]; o_dtb[i] = dtb[i]; o_wf[i] = ex2(afK1 - af) * dtf[i]; o_wb[i] = ex2(rbK1 - rb) * dtb[i]; }
        *(f32x4*)(vb + 0 * VS + t0) = o_af; *(f32x4*)(vb + 1 * VS + t0) = o_rb; *(f32x4*)(vb + 2 * VS + t0) = o_vtf; *(f32x4*)(vb + 3 * VS + t0) = o_vtb;
        *(f32x4*)(vb + 4 * VS + t0) = o_dtf; *(f32x4*)(vb + 5 * VS + t0) = o_dtb;
        *(f32x4*)(vb + 6 * VS + t0) = o_wf; *(f32x4*)(vb + 7 * VS + t0) = o_wb;
    }
    __syncthreads();
}

#define DPPF(oldv, srcv, ctrl, rmask) __builtin_bit_cast(float, __builtin_amdgcn_update_dpp(__builtin_bit_cast(int, (float)(oldv)), __builtin_bit_cast(int, (float)(srcv)), (ctrl), (rmask), 0xF, false))
__device__ __forceinline__ float sum8_dpp(float v) {
    v += DPPF(0.f, v, 0xB1, 0xF); v += DPPF(0.f, v, 0x4E, 0xF); v += DPPF(0.f, v, 0x141, 0xF); return v; }
__device__ __forceinline__ float wave_sum_dpp(float v) {
    v = sum8_dpp(v); v += DPPF(0.f, v, 0x140, 0xF);
    v += DPPF(0.f, v, 0x142, 0xA); v += DPPF(0.f, v, 0x143, 0xC);
    return __builtin_bit_cast(float, __builtin_amdgcn_readlane(__builtin_bit_cast(int, v), 63)); }
__device__ __forceinline__ float xor4_dpp(float x, bool lo) {
    const float a = DPPF(0.f, x, 0x104, 0xF), b = DPPF(0.f, x, 0x114, 0xF); return lo ? a : b; }
__device__ __forceinline__ void sincos_rev(float ang, float& sn, float& cs) {
    const double r = (double)ang * 0.15915494309189533577; const float fr = (float)(r - __builtin_rint(r));
    sn = __builtin_amdgcn_sinf(fr); cs = __builtin_amdgcn_cosf(fr);
}
__device__ __forceinline__ void p3_qkv(const Args& a, LAS unsigned char* lds) {
    const int tid = opaque_tid(), lane = tid & 63, wave = tid >> 6, hd = lane >> 3, sub = lane & 7;
    const bf16* proj = (const bf16*)(a.ws + WS_PROJ); const bf16* qraw = (const bf16*)(a.ws + WS_QRAW); const bf16* kvraw = (const bf16*)(a.ws + WS_KVRAW);
    bf16* Q = (bf16*)(a.ws + WS_HB); bf16* Kk = (bf16*)(a.ws + WS_K); bf16* Vt = (bf16*)(a.ws + WS_VT);
    LAS bf16* vtile = (LAS bf16*)lds;
    const float qscale = 0.10206207261596577f * LOG2E;
    float gq[12], gk[12], ifr[4];
#pragma unroll
    for (int jj = 0; jj < 3; ++jj)
#pragma unroll
        for (int e = 0; e < 4; ++e) { gq[4 * jj + e] = a.q_norm_g[4 * sub + 32 * jj + e] * qscale; gk[4 * jj + e] = a.k_norm_g[4 * sub + 32 * jj + e]; }
#pragma unroll
    for (int e = 0; e < 4; ++e) ifr[e] = exp2f(-(float)(2 * (4 * (sub & 3) + e)) * (13.287712379549449f / 32.f));
    const float sgn = (sub < 4) ? -1.f : 1.f;
    for (int item = blockIdx.x; item < T_ / 64; item += gridDim.x) {
        __syncthreads();
        for (int i0 = 0; i0 < 8; i0 += 4) {
          u32x2 cq_[4], q0_[4], q1_[4], q2_[4], k0_[4], k1_[4], k2_[4]; unsigned ckv_[4]; u32x4 vv_[4]; int pos_[4];
#pragma unroll
          for (int u = 0; u < 4; ++u) {
            const int t = item * 64 + wave * 8 + i0 + u; const bf16* pr = proj + (size_t)t * NPROJ;
            cq_[u] = *(const u32x2*)(pr + C_CQ + 4 * lane); ckv_[u] = *(const unsigned*)(pr + C_CKV + 2 * lane);
            q0_[u] = *(const u32x2*)(qraw + (size_t)t * 768 + hd * 96 + 4 * sub); q1_[u] = *(const u32x2*)(qraw + (size_t)t * 768 + hd * 96 + 4 * sub + 32); q2_[u] = *(const u32x2*)(qraw + (size_t)t * 768 + hd * 96 + 4 * sub + 64);
            k0_[u] = *(const u32x2*)(kvraw + (size_t)t * 1024 + hd * 128 + 4 * sub); k1_[u] = *(const u32x2*)(kvraw + (size_t)t * 1024 + hd * 128 + 4 * sub + 32); k2_[u] = *(const u32x2*)(pr + C_KPE + 4 * sub);
            vv_[u] = *(const u32x4*)(kvraw + (size_t)t * 1024 + hd * 128 + 64 + 8 * sub); pos_[u] = a.pos[t];
          }
#pragma unroll
          for (int u = 0; u < 4; ++u) {
            const int tl = wave * 8 + i0 + u, t = item * 64 + tl, b = t / S_, s = t % S_;
            const u32x2 cq = cq_[u], q0 = q0_[u], q1 = q1_[u], q2 = q2_[u], k0 = k0_[u], k1 = k1_[u], k2 = k2_[u]; const unsigned ckv = ckv_[u]; const u32x4 vv = vv_[u];
            float sq = bflo(cq.x) * bflo(cq.x) + bfhi(cq.x) * bfhi(cq.x) + bflo(cq.y) * bflo(cq.y) + bfhi(cq.y) * bfhi(cq.y);
            float sk = bflo(ckv) * bflo(ckv) + bfhi(ckv) * bfhi(ckv);
            const float rq = __builtin_amdgcn_rsqf(wave_sum_dpp(sq) * (1.f / 256.f) + EPS), rk = __builtin_amdgcn_rsqf(wave_sum_dpp(sk) * (1.f / 128.f) + EPS);
            const float p = (float)pos_[u];
            float sn[4], cs[4];
#pragma unroll
            for (int e = 0; e < 4; ++e) sincos_rev(p * ifr[e], sn[e], cs[e]);
            float v[12];
            v[0] = bflo(q0.x); v[1] = bfhi(q0.x); v[2] = bflo(q0.y); v[3] = bfhi(q0.y); v[4] = bflo(q1.x); v[5] = bfhi(q1.x); v[6] = bflo(q1.y); v[7] = bfhi(q1.y);
            v[8] = bflo(q2.x); v[9] = bfhi(q2.x); v[10] = bflo(q2.y); v[11] = bfhi(q2.y);
            float ss = 0.f;
#pragma unroll
            for (int j = 0; j < 12; ++j) { v[j] *= rq; ss += v[j] * v[j]; }
            ss = sum8_dpp(ss);
            float rn = __builtin_amdgcn_rsqf(ss * (1.f / 96.f) + EPS);
#pragma unroll
            for (int j = 0; j < 12; ++j) v[j] = v[j] * rn * gq[j];
#pragma unroll
            for (int e = 0; e < 4; ++e) { const float x = v[8 + e], pt = xor4_dpp(x, sub < 4); v[8 + e] = x * cs[e] + sgn * pt * sn[e]; }
            { bf16* qo = Q + ((size_t)(b * 8 + hd) * S_ + s) * 96 + 4 * sub;
#pragma unroll
              for (int jj = 0; jj < 3; ++jj) { u32x2 o; o.x = pk2(v[4 * jj], v[4 * jj + 1]); o.y = pk2(v[4 * jj + 2], v[4 * jj + 3]); *(u32x2*)(qo + 32 * jj) = o; } }
            v[0] = bflo(k0.x) * rk; v[1] = bfhi(k0.x) * rk; v[2] = bflo(k0.y) * rk; v[3] = bfhi(k0.y) * rk; v[4] = bflo(k1.x) * rk; v[5] = bfhi(k1.x) * rk; v[6] = bflo(k1.y) * rk; v[7] = bfhi(k1.y) * rk;
            v[8] = bflo(k2.x); v[9] = bfhi(k2.x); v[10] = bflo(k2.y); v[11] = bfhi(k2.y);
            ss = 0.f;
#pragma unroll
            for (int j = 0; j < 12; ++j) ss += v[j] * v[j];
            ss = sum8_dpp(ss);
            rn = __builtin_amdgcn_rsqf(ss * (1.f / 96.f) + EPS);
#pragma unroll
            for (int j = 0; j < 12; ++j) v[j] = v[j] * rn * gk[j];
#pragma unroll
            for (int e = 0; e < 4; ++e) { const float x = v[8 + e], pt = xor4_dpp(x, sub < 4); v[8 + e] = x * cs[e] + sgn * pt * sn[e]; }
            { bf16* ko = Kk + ((size_t)(b * 8 + hd) * S_ + s) * 96 + 4 * sub;
#pragma unroll
              for (int jj = 0; jj < 3; ++jj) { u32x2 o; o.x = pk2(v[4 * jj], v[4 * jj + 1]); o.y = pk2(v[4 * jj + 2], v[4 * jj + 3]); *(u32x2*)(ko + 32 * jj) = o; } }
            { LAS bf16* vt = vtile + (hd * 64 + 8 * sub) * 66 + tl;
              const unsigned p0 = pk2(bflo(vv.x) * rk, bfhi(vv.x) * rk), p1 = pk2(bflo(vv.y) * rk, bfhi(vv.y) * rk), p2 = pk2(bflo(vv.z) * rk, bfhi(vv.z) * rk), p3 = pk2(bflo(vv.w) * rk, bfhi(vv.w) * rk);
              vt[0 * 66] = (bf16)(p0 & 0xffffu); vt[1 * 66] = (bf16)(p0 >> 16); vt[2 * 66] = (bf16)(p1 & 0xffffu); vt[3 * 66] = (bf16)(p1 >> 16);
              vt[4 * 66] = (bf16)(p2 & 0xffffu); vt[5 * 66] = (bf16)(p2 >> 16); vt[6 * 66] = (bf16)(p3 & 0xffffu); vt[7 * 66] = (bf16)(p3 >> 16); }
          }
        }
        __syncthreads();
        { const int b = (item * 64) / S_, s0 = (item * 64) % S_; const int c8 = tid & 7;
#pragma unroll
          for (int k = 0; k < 8; ++k) { const int row = (tid >> 3) + 64 * k;
              const LAS unsigned* src = (const LAS unsigned*)(vtile + row * 66 + c8 * 8);
              u32x4 o; o.x = src[0]; o.y = src[1]; o.z = src[2]; o.w = src[3];
              *(u32x4*)(Vt + ((size_t)b * 512 + row) * S_ + s0 + 8 * c8) = o; } }
    }
    __syncthreads();
}
__device__ __forceinline__ short __attribute__((ext_vector_type(8))) scale8(const short __attribute__((ext_vector_type(8))) x, const f32x4 w0, const f32x4 w1) {
    const u32x4 v = __builtin_bit_cast(u32x4, x); u32x4 o;
    o.x = pk2(bflo(v.x) * w0.x, bfhi(v.x) * w0.y); o.y = pk2(bflo(v.y) * w0.z, bfhi(v.y) * w0.w); o.z = pk2(bflo(v.z) * w1.x, bfhi(v.z) * w1.y); o.w = pk2(bflo(v.w) * w1.z, bfhi(v.w) * w1.w);
    return __builtin_bit_cast(short __attribute__((ext_vector_type(8))), o);
}
__device__ __forceinline__ void ssd_chunk_states(const Args& a, LAS unsigned char* lds) {
    const int tid = opaque_tid(), lane = tid & 63, w = tid >> 6, r = lane & 31, hh = lane >> 5;
    const int nblk = w & 3, pblk = w >> 2;
    const bf16* Bt = (const bf16*)(a.ws + WS_BT); const bf16* Xt = (const bf16*)(a.ws + WS_XT);
    const float* vec = (const float*)(a.ws + WS_VEC);
    const size_t VS = (size_t)NB * 8 * S_;
    bf16* Sst = (bf16*)a.out;
    constexpr int ROWB = 528, XOFF = 128 * ROWB, WOFF = XOFF + 64 * ROWB;
    LAS float* wl = (LAS float*)(lds + WOFF);
    const int crow = tid >> 5, cc = tid & 31;
    for (int item = blockIdx.x; item < NB * 8 * 8; item += gridDim.x) {
        const int qb = item & 7, head = (item >> 3) & 7, b = item >> 6, g = head >> 2;
        const int L0 = qb * 256;
        const bf16* Ab = Bt + (size_t)(b * 2 + g) * 128 * S_ + L0;
        const bf16* Xb = Xt + (size_t)(b * 8 + head) * 64 * S_ + L0;
        u32x4 st[12];
#pragma unroll
        for (int i = 0; i < 8; ++i) st[i] = *(const u32x4*)(Ab + (size_t)(16 * i + crow) * S_ + 8 * cc);
#pragma unroll
        for (int i = 0; i < 4; ++i) st[8 + i] = *(const u32x4*)(Xb + (size_t)(16 * i + crow) * S_ + 8 * cc);
        const float wv = vec[(6 + (tid >> 8)) * VS + ((size_t)b * 8 + head) * S_ + L0 + (tid & 255)];
        __syncthreads();
#pragma unroll
        for (int i = 0; i < 8; ++i) *(LAS u32x4*)(lds + (16 * i + crow) * ROWB + 16 * cc) = st[i];
#pragma unroll
        for (int i = 0; i < 4; ++i) *(LAS u32x4*)(lds + XOFF + (16 * i + crow) * ROWB + 16 * cc) = st[8 + i];
        wl[tid] = wv;
        __syncthreads();
        f32x16 accf, accb;
#pragma unroll
        for (int i = 0; i < 16; ++i) { accf[i] = 0.f; accb[i] = 0.f; }
        const LAS unsigned char* ap = lds + (32 * nblk + r) * ROWB + 16 * hh;
        const LAS unsigned char* xp = lds + XOFF + (32 * pblk + r) * ROWB + 16 * hh;
#pragma unroll
        for (int u = 0; u < 16; ++u) {
            const bf16x8 A = *(const LAS bf16x8*)(ap + 32 * u), X = *(const LAS bf16x8*)(xp + 32 * u);
            const f32x4 F0 = *(const LAS f32x4*)(wl + 16 * u + 8 * hh), F1 = *(const LAS f32x4*)(wl + 16 * u + 8 * hh + 4);
            const f32x4 G0 = *(const LAS f32x4*)(wl + 256 + 16 * u + 8 * hh), G1 = *(const LAS f32x4*)(wl + 256 + 16 * u + 8 * hh + 4);
            accf = MFMA32(A, scale8(X, F0, F1), accf); accb = MFMA32(A, scale8(X, G0, G1), accb);
        }
        bf16* of = Sst + ((((size_t)(b * 8 + head) * 2 + 0) * 8 + qb) * 64 + 32 * pblk + r) * 128 + 32 * nblk + 4 * hh;
        bf16* ob = of + (size_t)8 * 64 * 128;
#pragma unroll
        for (int g4 = 0; g4 < 4; ++g4) {
            u32x2 v; v.x = pk2(accf[4 * g4], accf[4 * g4 + 1]); v.y = pk2(accf[4 * g4 + 2], accf[4 * g4 + 3]); *(u32x2*)(of + 8 * g4) = v;
            u32x2 q; q.x = pk2(accb[4 * g4], accb[4 * g4 + 1]); q.y = pk2(accb[4 * g4 + 2], accb[4 * g4 + 3]); *(u32x2*)(ob + 8 * g4) = q; }
    }
    __syncthreads();
}
__device__ __forceinline__ void ssd_state_scan(const Args& a) {
    const int tid = opaque_tid();
    const float* vec = (const float*)(a.ws + WS_VEC);
    const size_t VS = (size_t)NB * 8 * S_;
    const bf16* Sst = (const bf16*)a.out; bf16* Hst = (bf16*)a.out + HST_OFF;
    for (int e = blockIdx.x * NTHREADS + tid; e < NB * 8 * 2 * 1024; e += gridDim.x * NTHREADS) {
        const int seq = e >> 10, off = (e & 1023) * 8, dir = seq & 1, bh = seq >> 1;
        const float* vb = vec + (size_t)bh * S_;
        const size_t base = (size_t)seq * 8 * 8192 + off;
        u32x4 sv[8]; float dec[8];
#pragma unroll
        for (int i = 0; i < 8; ++i) { const int qb = dir ? 7 - i : i; sv[i] = *(const u32x4*)(Sst + base + (size_t)qb * 8192);
            const int L0 = qb * 256, L1 = L0 + 255;
            if (dir == 0) dec[i] = ex2(vb[L1] - (qb ? vb[L0 - 1] : 0.f)); else dec[i] = ex2(vb[VS + L0] - (qb < 7 ? vb[VS + L1 + 1] : 0.f)); }
        float h[8];
#pragma unroll
        for (int k = 0; k < 8; ++k) h[k] = 0.f;
#pragma unroll
        for (int i = 0; i < 8; ++i) { const int qb = dir ? 7 - i : i;
            u32x4 o; o.x = pk2(h[0], h[1]); o.y = pk2(h[2], h[3]); o.z = pk2(h[4], h[5]); o.w = pk2(h[6], h[7]);
            *(u32x4*)(Hst + base + (size_t)qb * 8192) = o;
            const u32x4 v = sv[i]; const float d = dec[i];
            h[0] = h[0] * d + bflo(v.x); h[1] = h[1] * d + bfhi(v.x); h[2] = h[2] * d + bflo(v.y); h[3] = h[3] * d + bfhi(v.y);
            h[4] = h[4] * d + bflo(v.z); h[5] = h[5] * d + bfhi(v.z); h[6] = h[6] * d + bflo(v.w); h[7] = h[7] * d + bfhi(v.w); }
    }
}

__device__ __forceinline__ bf16x8 pack8(float a0, float a1, float a2, float a3, float a4, float a5, float a6, float a7) {
    u32x4 p; p.x = pk2(a0, a1); p.y = pk2(a2, a3); p.z = pk2(a4, a5); p.w = pk2(a6, a7); return __builtin_bit_cast(bf16x8, p);
}
__device__ __forceinline__ bf16x8 ld_vfrag(const LAS unsigned char* p) {
    return *(const LAS bf16x8*)p;
}
constexpr int AT_KROW = 208, AT_VROW = 144, AT_KBYTES = 64 * AT_KROW, AT_BUF = AT_KBYTES + 64 * AT_VROW;
__device__ __forceinline__ void attn_item(LAS unsigned char* lds, const bf16* Q, const bf16* Kg, const bf16* Vt, bf16* O, float* ssqa, int b, int h, int qb, float mb) {
    const int tid = opaque_tid(), lane = tid & 63, w = tid >> 6, r = lane & 31, hh = lane >> 5;
    const size_t bh = (size_t)(b * 8 + h);
    const int qrow = qb * 256 + w * 32 + r;
    bf16x8 qf[6];
    { const bf16* Qp = Q + (bh * S_ + qrow) * 96 + 8 * hh;
#pragma unroll
      for (int s = 0; s < 6; ++s) qf[s] = *(const bf16x8*)(Qp + 16 * s); }
    const unsigned char* Kp = (const unsigned char*)(Kg + bh * S_ * 96);
    const bf16* Vp = Vt + bh * 64 * S_;
    const int vrow = tid >> 3, vc8 = tid & 7;
    const int kc0 = tid, kc1 = tid + 512;
    const unsigned koff0 = (kc0 / 12) * AT_KROW + (kc0 % 12) * 16, koff1 = (kc1 / 12) * AT_KROW + (kc1 % 12) * 16;
    const unsigned voff = AT_KBYTES + vrow * AT_VROW + (vc8 >> 1) * 32 + (vc8 & 1) * 8;
    u32x4 kr0, kr1 = {0, 0, 0, 0}, vr;
#define AT_LOAD(j) do { kr0 = *(const u32x4*)(Kp + (size_t)(j) * 12288 + kc0 * 16); if (tid < 256) kr1 = *(const u32x4*)(Kp + (size_t)(j) * 12288 + kc1 * 16); \
        vr = *(const u32x4*)(Vp + (size_t)vrow * S_ + (j) * 64 + vc8 * 8); } while (0)
#define AT_STORE(buf) do { LAS unsigned char* bb = lds + (buf) * AT_BUF; *(LAS u32x4*)(bb + koff0) = kr0; if (tid < 256) *(LAS u32x4*)(bb + koff1) = kr1; \
        *(LAS u32x2*)(bb + voff) = (u32x2){vr.x, vr.y}; *(LAS u32x2*)(bb + voff + 16) = (u32x2){vr.z, vr.w}; } while (0)
    __syncthreads();
    AT_LOAD(0); AT_STORE(0);
    __syncthreads();
    f32x16 o0, o1, nmbv;
#pragma unroll
    for (int i = 0; i < 16; ++i) { o0[i] = 0.f; o1[i] = 0.f; nmbv[i] = -mb; }
    f32x2 ls2 = {0.f, 0.f};
    for (int j = 0; j < 32; ++j) {
        if (j + 1 < 32) AT_LOAD(j + 1);
        const LAS unsigned char* kb_ = lds + (j & 1) * AT_BUF;
        const LAS unsigned char* vb_ = kb_ + AT_KBYTES;
        bf16x8 kf[6];
#pragma unroll
        for (int s = 0; s < 6; ++s) kf[s] = *(const LAS bf16x8*)(kb_ + r * AT_KROW + 32 * s + 16 * hh);
#pragma unroll
        for (int kb = 0; kb < 2; ++kb) {
            f32x16 sT = MFMA32(kf[0], qf[0], nmbv);
#pragma unroll
            for (int s = 1; s < 6; ++s) sT = MFMA32(kf[s], qf[s], sT);
            bf16x8 vf[2][2];
#pragma unroll
            for (int ks = 0; ks < 2; ++ks) { vf[ks][0] = ld_vfrag(vb_ + r * AT_VROW + (2 * kb + ks) * 32 + 16 * hh); vf[ks][1] = ld_vfrag(vb_ + (32 + r) * AT_VROW + (2 * kb + ks) * 32 + 16 * hh); }
            if (kb == 0) {
#pragma unroll
                for (int s = 0; s < 6; ++s) kf[s] = *(const LAS bf16x8*)(kb_ + (32 + r) * AT_KROW + 32 * s + 16 * hh);
            }
            __builtin_amdgcn_sched_barrier(0);
#pragma unroll
            for (int i = 0; i < 16; i += 2) { sT[i] = ex2(sT[i]); sT[i + 1] = ex2(sT[i + 1]); ls2 += (f32x2){sT[i], sT[i + 1]}; }
            __builtin_amdgcn_sched_barrier(0);
#pragma unroll
            for (int ks = 0; ks < 2; ++ks) {
                const bf16x8 pf = pack8(sT[8 * ks], sT[8 * ks + 1], sT[8 * ks + 2], sT[8 * ks + 3], sT[8 * ks + 4], sT[8 * ks + 5], sT[8 * ks + 6], sT[8 * ks + 7]);
                o0 = MFMA32(vf[ks][0], pf, o0); o1 = MFMA32(vf[ks][1], pf, o1);
            }
        }
        if (j + 1 < 32) AT_STORE((j + 1) & 1);
        __syncthreads();
    }
    float lsum = ls2.x + ls2.y;
#undef AT_LOAD
#undef AT_STORE
    lsum += __shfl_xor(lsum, 32);
    const float inv = 1.f / lsum;
    LAS unsigned char* img = lds + w * (32 * 272);
    { float sq = 0.f;
#pragma unroll
      for (int i = 0; i < 16; ++i) { const float p0 = o0[i] * inv, p1 = o1[i] * inv; sq += p0 * p0 + p1 * p1; }
      sq += __shfl_xor(sq, 32);
      if (hh == 0) atomicAdd(ssqa + (size_t)b * S_ + qrow, sq); }
#pragma unroll
    for (int g4 = 0; g4 < 4; ++g4) {
        *(LAS f32x4*)(img + r * 272 + (8 * g4 + 4 * hh) * 4) = (f32x4){o0[4 * g4] * inv, o0[4 * g4 + 1] * inv, o0[4 * g4 + 2] * inv, o0[4 * g4 + 3] * inv};
        *(LAS f32x4*)(img + r * 272 + (32 + 8 * g4 + 4 * hh) * 4) = (f32x4){o1[4 * g4] * inv, o1[4 * g4 + 1] * inv, o1[4 * g4 + 2] * inv, o1[4 * g4 + 3] * inv};
    }
    const int er = lane >> 3, ec = lane & 7;
#pragma unroll
    for (int k = 0; k < 4; ++k) {
        const f32x4 v0 = *(const LAS f32x4*)(img + (er + 8 * k) * 272 + ec * 32), v1 = *(const LAS f32x4*)(img + (er + 8 * k) * 272 + ec * 32 + 16);
        u32x4 o; o.x = pk2(v0[0], v0[1]); o.y = pk2(v0[2], v0[3]); o.z = pk2(v1[0], v1[1]); o.w = pk2(v1[2], v1[3]);
        *(u32x4*)(O + ((size_t)b * S_ + qb * 256 + w * 32 + er + 8 * k) * 1024 + h * 64 + 8 * ec) = o;
    }
}

constexpr int SD_BROW = 272, SD_XROW = 144, SD_BBYTES = 64 * SD_BROW, SD_XBYTES = 64 * SD_XROW, SD_VEC = SD_BBYTES + 2 * SD_XBYTES, SD_BUF = SD_VEC + 2 * 6 * 256;
__device__ __forceinline__ void ssd_item(LAS unsigned char* lds, const Args& a, int b, int hp, int qb) {
    const int tid = opaque_tid(), lane = tid & 63, w = tid >> 6, r = lane & 31, hh = lane >> 5;
    const int g = hp >> 1, h0 = hp * 2;
    const bf16* Bm = (const bf16*)(a.ws + WS_BM); const bf16* Cm = (const bf16*)(a.ws + WS_CM); const bf16* Xt = (const bf16*)(a.ws + WS_XT);
    const float* vec = (const float*)(a.ws + WS_VEC);
    const size_t VS = (size_t)NB * 8 * S_;
    const int l0 = qb * 256 + w * 32, l = l0 + r;
    bf16x8 cf[8];
    { const bf16* Cp = Cm + ((size_t)(b * 2 + g) * S_ + l) * 128 + 8 * hh;
#pragma unroll
      for (int s = 0; s < 8; ++s) cf[s] = *(const bf16x8*)(Cp + 16 * s); }
    float afl[2], rbl[2], dsk[2];
#pragma unroll
    for (int hd = 0; hd < 2; ++hd) { const float* vb = vec + ((size_t)b * 8 + h0 + hd) * S_; afl[hd] = vb[l]; rbl[hd] = vb[VS + l]; dsk[hd] = a.d_skip[h0 + hd]; }
    const unsigned char* Bp = (const unsigned char*)(Bm + (size_t)(b * 2 + g) * S_ * 128);
    const int xrow = tid >> 3, xc8 = tid & 7;
    const bf16* Xp0 = Xt + ((size_t)(b * 8 + h0) * 64 + xrow) * S_ + xc8 * 8;
    const bf16* Xp1 = Xp0 + (size_t)64 * S_;
    const int bc0 = tid, bc1 = tid + 512;
    const unsigned boff0 = (bc0 >> 4) * SD_BROW + (bc0 & 15) * 16, boff1 = (bc1 >> 4) * SD_BROW + (bc1 & 15) * 16;
    const unsigned xoff = SD_BBYTES + xrow * SD_XROW + (xc8 >> 1) * 32 + (xc8 & 1) * 8;
    const int vhd = tid / 96, vrem = tid % 96, varr = vrem >> 4, vc = vrem & 15;
    const float* vsrc = vec + (size_t)varr * VS + ((size_t)b * 8 + h0 + vhd) * S_ + 4 * vc;
    const unsigned voff = SD_VEC + ((vhd * 6 + varr) * 64 + 4 * vc) * 4;
    u32x4 br0, br1, xr0, xr1; f32x4 vr = {0.f, 0.f, 0.f, 0.f};
#define SD_LOAD(j) do { br0 = *(const u32x4*)(Bp + (size_t)(j) * 16384 + bc0 * 16); br1 = *(const u32x4*)(Bp + (size_t)(j) * 16384 + bc1 * 16); \
        xr0 = *(const u32x4*)(Xp0 + (j) * 64); xr1 = *(const u32x4*)(Xp1 + (j) * 64); if (tid < 192) vr = *(const f32x4*)(vsrc + (j) * 64); } while (0)
#define SD_STORE(buf) do { LAS unsigned char* bb = lds + (buf) * SD_BUF; *(LAS u32x4*)(bb + boff0) = br0; *(LAS u32x4*)(bb + boff1) = br1; \
        *(LAS u32x2*)(bb + xoff) = (u32x2){xr0.x, xr0.y}; *(LAS u32x2*)(bb + xoff + 16) = (u32x2){xr0.z, xr0.w}; \
        *(LAS u32x2*)(bb + xoff + SD_XBYTES) = (u32x2){xr1.x, xr1.y}; *(LAS u32x2*)(bb + xoff + SD_XBYTES + 16) = (u32x2){xr1.z, xr1.w}; \
        if (tid < 192) *(LAS f32x4*)(bb + voff) = vr; } while (0)
    const int j0 = qb * 4, j1 = j0 + 4;
    __syncthreads();
    SD_LOAD(j0); SD_STORE(j0 & 1);
    __syncthreads();
    f32x16 y[2][2], zero16;
#pragma unroll
    for (int i = 0; i < 16; ++i) zero16[i] = 0.f;
#pragma unroll
    for (int i = 0; i < 16; ++i) { y[0][0][i] = 0.f; y[0][1][i] = 0.f; y[1][0][i] = 0.f; y[1][1][i] = 0.f; }
    for (int j = j0; j < j1; ++j) {
        if (j + 1 < j1) SD_LOAD(j + 1);
        const LAS unsigned char* bb = lds + (j & 1) * SD_BUF;
        const int key0 = j * 64;
        const int type = (key0 + 63 < l0) ? 0 : ((key0 > l0 + 31) ? 1 : 2);
#pragma unroll
        for (int kb = 0; kb < 2; ++kb) {
            f32x16 sT;
#pragma unroll
            for (int i = 0; i < 16; ++i) sT[i] = 0.f;
#pragma unroll
            for (int s = 0; s < 8; ++s) { const bf16x8 bf_ = *(const LAS bf16x8*)(bb + (32 * kb + r) * SD_BROW + 32 * s + 16 * hh); sT = MFMA32(bf_, cf[s], sT); }
#pragma unroll
            for (int hd = 0; hd < 2; ++hd) {
                const LAS float* vv = (const LAS float*)(bb + SD_VEC + hd * 6 * 256);
                const LAS unsigned char* xb = bb + SD_BBYTES + hd * SD_XBYTES;
                float p[16];
                if (type != 2) {
                    const float coef = (type == 0) ? ex2(afl[hd] - vv[63]) : ex2(rbl[hd] - vv[64]);
                    const LAS float* vt = vv + (type == 0 ? 128 : 192) + 32 * kb + 4 * hh;
#pragma unroll
                    for (int g4 = 0; g4 < 4; ++g4) { const f32x4 t4 = *(const LAS f32x4*)(vt + 8 * g4);
#pragma unroll
                        for (int e = 0; e < 4; ++e) p[4 * g4 + e] = sT[4 * g4 + e] * (t4[e] * coef); }
                } else {
#pragma unroll
                    for (int g4 = 0; g4 < 4; ++g4) {
                        const int kk = 32 * kb + 8 * g4 + 4 * hh;
                        const f32x4 af4 = *(const LAS f32x4*)(vv + kk), rb4 = *(const LAS f32x4*)(vv + 64 + kk), df4 = *(const LAS f32x4*)(vv + 256 + kk), db4 = *(const LAS f32x4*)(vv + 320 + kk);
#pragma unroll
                        for (int e = 0; e < 4; ++e) {
                            const int s = key0 + kk + e;
                            const bool fwd = (s <= l);
                            const float arg = fwd ? (afl[hd] - af4[e]) : (rbl[hd] - rb4[e]);
                            float wgt = ex2(fminf(arg, 0.f)) * (fwd ? df4[e] : db4[e]);
                            if (s == l) wgt += db4[e];
                            float pv = sT[4 * g4 + e] * wgt;
                            if (s == l) pv += dsk[hd];
                            p[4 * g4 + e] = pv;
                        }
                        __builtin_amdgcn_sched_barrier(0);
                    }
                }
#pragma unroll
                for (int ks = 0; ks < 2; ++ks) {
                    const bf16x8 pf = pack8(p[8 * ks], p[8 * ks + 1], p[8 * ks + 2], p[8 * ks + 3], p[8 * ks + 4], p[8 * ks + 5], p[8 * ks + 6], p[8 * ks + 7]);
                    const bf16x8 x0 = ld_vfrag(xb + r * SD_XROW + (2 * kb + ks) * 32 + 16 * hh);
                    const bf16x8 x1 = ld_vfrag(xb + (32 + r) * SD_XROW + (2 * kb + ks) * 32 + 16 * hh);
                    y[hd][0] = MFMA32(x0, pf, y[hd][0]); y[hd][1] = MFMA32(x1, pf, y[hd][1]);
                }
            }
        }
        if (j + 1 < j1) SD_STORE((j + 1) & 1);
        __syncthreads();
    }
    {
        const bf16* Hst = (const bf16*)a.out + HST_OFF;
        const int Lb = qb * 256;
        u32x4 hreg[8];
#pragma unroll
        for (int tq = 0; tq < 4; ++tq)
#pragma unroll
            for (int i = 0; i < 2; ++i) { const int id = tid + 512 * i;
                hreg[2 * tq + i] = *(const u32x4*)(Hst + ((((size_t)(b * 8 + h0 + (tq >> 1)) * 2 + (tq & 1)) * 8 + qb) * 64) * 128 + (size_t)id * 8); }
#pragma unroll
        for (int tq = 0; tq < 4; ++tq)
#pragma unroll
            for (int i = 0; i < 2; ++i) { const int id = tid + 512 * i; *(LAS u32x4*)(lds + tq * (64 * 272) + (id >> 4) * 272 + (id & 15) * 16) = hreg[2 * tq + i]; }
        __syncthreads();
#pragma unroll
        for (int hd = 0; hd < 2; ++hd) {
            const float* vb = vec + ((size_t)b * 8 + h0 + hd) * S_;
            const float uf = ex2(afl[hd] - (qb ? vb[Lb - 1] : 0.f)), ub = ex2(rbl[hd] - (qb < 7 ? vb[VS + Lb + 256] : 0.f));
#pragma unroll
            for (int dir = 0; dir < 2; ++dir) {
                const LAS unsigned char* hp = lds + (hd * 2 + dir) * (64 * 272) + r * 272 + 16 * hh;
                const float uu = dir ? ub : uf;
#pragma unroll
                for (int db = 0; db < 2; ++db) {
                    f32x16 z = zero16;
#pragma unroll
                    for (int s = 0; s < 8; ++s) { const bf16x8 hf = *(const LAS bf16x8*)(hp + db * 32 * 272 + 32 * s); z = MFMA32(hf, cf[s], z); }
#pragma unroll
                    for (int i = 0; i < 16; ++i) y[hd][db][i] += uu * z[i];
                }
            }
        }
    }
#undef SD_LOAD
#undef SD_STORE
    const bf16* proj = (const bf16*)(a.ws + WS_PROJ); bf16* YG = (bf16*)(a.ws + WS_MIXRAW) + 512; float* ssqy = (float*)(a.ws + WS_SSQY);
    __syncthreads();
    LAS unsigned char* img = lds + w * (32 * 528);
#pragma unroll
    for (int hd = 0; hd < 2; ++hd)
#pragma unroll
        for (int db = 0; db < 2; ++db)
#pragma unroll
            for (int g4 = 0; g4 < 4; ++g4)
                *(LAS f32x4*)(img + r * 528 + (hd * 64 + 32 * db + 8 * g4 + 4 * hh) * 4) = (f32x4){y[hd][db][4 * g4], y[hd][db][4 * g4 + 1], y[hd][db][4 * g4 + 2], y[hd][db][4 * g4 + 3]};
    const int er = lane >> 4, ec = lane & 15;
    u32x4 zz[8];
#pragma unroll
    for (int k = 0; k < 8; ++k) zz[k] = *(const u32x4*)(proj + ((size_t)b * S_ + l0 + er + 4 * k) * NPROJ + C_Z + h0 * 64 + 8 * ec);
#pragma unroll
    for (int k = 0; k < 8; ++k) {
        const f32x4 v0 = *(const LAS f32x4*)(img + (er + 4 * k) * 528 + ec * 32), v1 = *(const LAS f32x4*)(img + (er + 4 * k) * 528 + ec * 32 + 16);
        const u32x4 z = zz[k]; u32x4 o;
        const float g0 = v0[0] * silu(bflo(z.x)), g1 = v0[1] * silu(bfhi(z.x)), g2 = v0[2] * silu(bflo(z.y)), g3 = v0[3] * silu(bfhi(z.y));
        const float g4_ = v1[0] * silu(bflo(z.z)), g5 = v1[1] * silu(bfhi(z.z)), g6 = v1[2] * silu(bflo(z.w)), g7 = v1[3] * silu(bfhi(z.w));
        o.x = pk2(g0, g1); o.y = pk2(g2, g3); o.z = pk2(g4_, g5); o.w = pk2(g6, g7);
        *(u32x4*)(YG + ((size_t)b * S_ + l0 + er + 4 * k) * 1024 + h0 * 64 + 8 * ec) = o;
        float sq = (g0 * g0 + g1 * g1) + (g2 * g2 + g3 * g3) + (g4_ * g4_ + g5 * g5) + (g6 * g6 + g7 * g7);
        sq += __shfl_xor(sq, 1); sq += __shfl_xor(sq, 2); sq += __shfl_xor(sq, 4); sq += __shfl_xor(sq, 8);
        if (ec == 0) atomicAdd(ssqy + 2 * ((size_t)b * S_ + l0 + er + 4 * k) + g, sq);
    }
}

__device__ __forceinline__ void p5_mix(const Args& a) {
    const int tid = opaque_tid(), lane = tid & 63, wave = tid >> 6;
    const int gw = blockIdx.x * NWAVES + wave, NGW = gridDim.x * NWAVES;
    const bf16* AO = (const bf16*)(a.ws + WS_ATTNO); const bf16* YG = (const bf16*)(a.ws + WS_YG); bf16* MIX = (bf16*)(a.ws + WS_HB);
    float ga[8], gs[8];
#pragma unroll
    for (int e = 0; e < 8; ++e) { ga[e] = a.attn_out_g[8 * lane + e]; gs[e] = a.ssm_norm_g[8 * lane + e]; }
    for (int t0 = gw; t0 < T_; t0 += 4 * NGW) {
        u32x4 avv[4], yvv[4];
#pragma unroll
        for (int u = 0; u < 4; ++u) { const int t = t0 + u * NGW; if (t < T_) { avv[u] = *(const u32x4*)(AO + (size_t)t * 512 + 8 * lane); yvv[u] = *(const u32x4*)(YG + (size_t)t * 512 + 8 * lane); } else { avv[u] = (u32x4){0u, 0u, 0u, 0u}; yvv[u] = avv[u]; } }
#pragma unroll
        for (int u = 0; u < 4; ++u) {
        const int t = t0 + u * NGW; if (t >= T_) break;
        const u32x4 av = avv[u], yv = yvv[u];
        float x[8], yy[8];
        x[0] = bflo(av.x); x[1] = bfhi(av.x); x[2] = bflo(av.y); x[3] = bfhi(av.y); x[4] = bflo(av.z); x[5] = bfhi(av.z); x[6] = bflo(av.w); x[7] = bfhi(av.w);
        yy[0] = bflo(yv.x); yy[1] = bfhi(yv.x); yy[2] = bflo(yv.y); yy[3] = bfhi(yv.y); yy[4] = bflo(yv.z); yy[5] = bfhi(yv.z); yy[6] = bflo(yv.w); yy[7] = bfhi(yv.w);
        float sa = 0.f, sy = 0.f;
#pragma unroll
        for (int e = 0; e < 8; ++e) { sa += x[e] * x[e]; sy += yy[e] * yy[e]; }
        sa = wave_sum(sa);
#pragma unroll
        for (int o = 1; o < 32; o <<= 1) sy += __shfl_xor(sy, o);
        const float ra = 1.f / sqrtf(sa * (1.f / 512.f) + EPS), ry = 1.f / sqrtf(sy * (1.f / 256.f) + EPS);
        u32x4 oa, oy;
        oa.x = pk2(x[0] * ra * ga[0], x[1] * ra * ga[1]); oa.y = pk2(x[2] * ra * ga[2], x[3] * ra * ga[3]); oa.z = pk2(x[4] * ra * ga[4], x[5] * ra * ga[5]); oa.w = pk2(x[6] * ra * ga[6], x[7] * ra * ga[7]);
        oy.x = pk2(yy[0] * ry * gs[0], yy[1] * ry * gs[1]); oy.y = pk2(yy[2] * ry * gs[2], yy[3] * ry * gs[3]); oy.z = pk2(yy[4] * ry * gs[4], yy[5] * ry * gs[5]); oy.w = pk2(yy[6] * ry * gs[6], yy[7] * ry * gs[7]);
        *(u32x4*)(MIX + (size_t)t * D_ + 8 * lane) = oa; *(u32x4*)(MIX + (size_t)t * D_ + 512 + 8 * lane) = oy;
    }
        }
}

#define XB_TMO      128
#define XB_XCNT(j)  (256  + 64 * (j))
#define XB_XSUB(j)  (1280 + 64 * (j))
#define XB_XGEN(j)  (2304 + 64 * (j))
#define XB_TOP      3328
#define XB_TOPGEN   3392
#define XCD_BAR_WORDS 3456
#define XB_SPIN_CAP (1u << 18)

__device__ __forceinline__ unsigned xb_ld(unsigned* p)              { return __hip_atomic_load(p, __ATOMIC_RELAXED, __HIP_MEMORY_SCOPE_AGENT); }
__device__ __forceinline__ unsigned xb_add(unsigned* p, unsigned v) { return __hip_atomic_fetch_add(p, v, __ATOMIC_RELAXED, __HIP_MEMORY_SCOPE_AGENT); }
__device__ __forceinline__ unsigned xb_xcc_id() { return (unsigned)__builtin_amdgcn_s_getreg((3 << 11) | 20) & 0xFu; }
#define XB_SPIN(cond, bar) do { unsigned _sp = 0; while (cond) { __builtin_amdgcn_s_sleep(1); \
    if ((++_sp & 255u) == 0u) { if (xb_ld(&(bar)[XB_TMO])) break; if (_sp > XB_SPIN_CAP) { atomicAdd(&(bar)[XB_TMO], 1u); break; } } } } while (0)

struct XcdBarrier {
    unsigned* bar; unsigned x;
    volatile LAS unsigned* st;
};

__device__ __forceinline__ XcdBarrier xcd_barrier_post(unsigned* bar, volatile LAS unsigned* st) {
    XcdBarrier b; b.bar = bar; b.x = xb_xcc_id(); b.st = st;
    if (threadIdx.x == 0) (void)xb_add(&bar[XB_XCNT(b.x)], 1u);
    return b;
}
__device__ __forceinline__ void xcd_barrier_complete(unsigned* bar, unsigned x, unsigned& nloc, unsigned& nx) {
    const unsigned G = gridDim.x * gridDim.y * gridDim.z;
    unsigned sum, cnt, mine, sp = 0u;
    for (;;) {
        sum = 0u; cnt = 0u; mine = 0u;
#pragma unroll
        for (unsigned j = 0; j < 16; ++j) { const unsigned c = xb_ld(&bar[XB_XCNT(j)]); sum += c; cnt += (c > 0u) ? 1u : 0u; mine = (j == x) ? c : mine; }
        if (sum == G) break;
        __builtin_amdgcn_s_sleep(1);
        if ((++sp & 255u) == 0u) { if (xb_ld(&bar[XB_TMO])) break; if (sp > XB_SPIN_CAP) { atomicAdd(&bar[XB_TMO], 1u); break; } }
    }
    nloc = mine > 0u ? mine : 1u; nx = cnt > 0u ? cnt : 1u;
}

__device__ __forceinline__ void xcd_barrier(const XcdBarrier& b) {
    asm volatile("s_waitcnt vmcnt(0)" ::: "memory");
    __syncthreads();
    if (threadIdx.x == 0) {
        unsigned* bar = b.bar;
        __builtin_amdgcn_s_waitcnt(0);
        unsigned nloc = b.st[0], nx = b.st[1];
        if (nloc == 0u) { xcd_barrier_complete(bar, b.x, nloc, nx); b.st[0] = nloc; b.st[1] = nx; }
        const unsigned old = xb_add(&bar[XB_XSUB(b.x)], 1u);
        const unsigned gen = old / nloc;
        if (old + 1u == (gen + 1u) * nloc) {
            __builtin_amdgcn_fence(__ATOMIC_RELEASE, "agent");
            asm volatile("s_waitcnt vmcnt(0)" ::: "memory");
            const unsigned og = xb_add(&bar[XB_TOP], 1u);
            const unsigned tg = og / nx;
            if (og + 1u == (tg + 1u) * nx) xb_add(&bar[XB_TOPGEN], 1u);
            else XB_SPIN(xb_ld(&bar[XB_TOPGEN]) == tg, bar);
            __builtin_amdgcn_fence(__ATOMIC_ACQUIRE, "agent");
            xb_add(&bar[XB_XGEN(b.x)], 1u);
            asm volatile("s_waitcnt vmcnt(0)" ::: "memory");
        } else {
            XB_SPIN(xb_ld(&bar[XB_XGEN(b.x)]) == gen, bar);
            __builtin_amdgcn_fence(__ATOMIC_ACQUIRE, "agent");
            asm volatile("s_waitcnt vmcnt(0)" ::: "memory");
        }
    }
    __syncthreads();
}

__device__ __forceinline__ void split_arrive(unsigned* cnt) {
    asm volatile("s_waitcnt vmcnt(0)" ::: "memory");
    __syncthreads();
    if (threadIdx.x == 0) { __builtin_amdgcn_fence(__ATOMIC_RELEASE, "agent"); asm volatile("s_waitcnt vmcnt(0)" ::: "memory"); (void)__hip_atomic_fetch_add(cnt, 1u, __ATOMIC_RELAXED, __HIP_MEMORY_SCOPE_AGENT); }
}
__device__ __forceinline__ void split_wait(unsigned* cnt, unsigned want) {
    if (threadIdx.x == 0) { unsigned sp = 0; while (__hip_atomic_load(cnt, __ATOMIC_RELAXED, __HIP_MEMORY_SCOPE_AGENT) < want) { __builtin_amdgcn_s_sleep(1); if (++sp > (1u << 22)) break; }
        __builtin_amdgcn_fence(__ATOMIC_ACQUIRE, "agent"); asm volatile("s_waitcnt vmcnt(0)" ::: "memory"); }
    __syncthreads();
}

#define REP_P0 1
#define REP_P23 1
#define REP_P5 1
#ifndef REP_P4
#define REP_P4 1
#endif
__global__ void __launch_bounds__(NTHREADS, 2) fwd_megakernel(Args a) {
    extern __shared__ __attribute__((aligned(16))) unsigned char lds_raw[];
    LAS unsigned char* lds = (LAS unsigned char*)lds_raw;
    cg::grid_group grid = cg::this_grid();
    unsigned char* ws = a.ws;
    const int G = gridDim.x, bx = blockIdx.x;
    const int tid = opaque_tid(), lane = tid & 63, wave = tid >> 6;
    volatile LAS unsigned* MISC = (volatile LAS unsigned*)(lds + MISC_OFF);
    if (threadIdx.x < 16) MISC[threadIdx.x] = 0u;
    __syncthreads();
    XcdBarrier bar = xcd_barrier_post((unsigned*)(ws + WS_BAR), MISC + 8);
#define GRID_BAR() xcd_barrier(bar)
    for (int rep = 0; rep < REP_P0; ++rep) {
    p0_prologue(a, lds);
    if (a.ws == nullptr) grid.sync();
    GRID_BAR();
    }
    { pg8::Gemm g{(const bf16*)(ws + WS_HB), (const bf16*)(ws + WS_WIN), T_, NPROJ, D_, D_}; pg8::StaticOrder S; S.init(T_, NPROJ, G, bx);
      pg8::EpiBf16<2> E{(bf16*)(ws + WS_PROJ), NPROJ, (float*)(ws + WS_DTRAW)};
      pg8::gemm_phase<pg8::EpiBf16<2>, pg8::StaticOrder, true, true>(lds, g, S, E); }
    GRID_BAR();
    for (int rep = 0; rep < REP_P23; ++rep) {
    { pg8::Gemm g{(const bf16*)(ws + WS_PROJ) + C_CQ, (const bf16*)(ws + WS_WUQ), T_, 768, 256, NPROJ}; pg8::StaticOrder S; S.init(T_, 768, G, bx);
      pg8::EpiBf16<0> E{(bf16*)(ws + WS_QRAW), 768, nullptr};
      pg8::gemm_phase<pg8::EpiBf16<0>, pg8::StaticOrder, true, true>(lds, g, S, E); }
    { pg8::Gemm g{(const bf16*)(ws + WS_PROJ) + C_CKV, (const bf16*)(ws + WS_WUKV), T_, 1024, 128, NPROJ}; pg8::StaticOrder S; S.init(T_, 1024, G, bx);
      pg8::EpiBf16<0> E{(bf16*)(ws + WS_KVRAW), 1024, nullptr};
      pg8::gemm_phase<pg8::EpiBf16<0>, pg8::StaticOrder, true, true>(lds, g, S, E); }
    prep_scan(a, lds);
    prep_conv(a, lds);
    GRID_BAR();
    p3_qkv(a, lds);
    ssd_chunk_states(a, lds);
    GRID_BAR();
    }
    for (int rep = 0; rep < REP_P4; ++rep) {
        float mq = 0.f, mk = 0.f;
        for (int i = 0; i < 96; ++i) { mq = fmaxf(mq, fabsf(a.q_norm_g[i])); mk = fmaxf(mk, fabsf(a.k_norm_g[i])); }
        const float mb = fminf(96.f * mq * mk * 0.10206207261596577f * LOG2E, 80.f);
        unsigned* s2cnt = (unsigned*)(ws + WS_BAR) + XCD_BAR_WORDS + 64;
        p0b_mlp_weights(a, lds);
        ssd_state_scan(a);
        split_arrive(s2cnt);
        for (int u = bx; u < 512; u += G) { const int qb = u & 7, h = (u >> 3) & 7, b = u >> 6; attn_item(lds, (const bf16*)(ws + WS_HB), (const bf16*)(ws + WS_K), (const bf16*)(ws + WS_VT), (bf16*)(ws + WS_MIXRAW), (float*)(ws + WS_SSQA), b, h, qb, mb); }
        split_wait(s2cnt, (unsigned)G * (unsigned)(rep + 1));
        for (int it = bx; it < 256; it += G) { const int qb = it & 7, hp = (it >> 3) & 3, b = it >> 5; ssd_item(lds, a, b, hp, qb); }
    GRID_BAR();
    }
    { pg8::Gemm g{(const bf16*)(ws + WS_MIXRAW), (const bf16*)(ws + WS_WOUT), T_, D_, D_, D_}; pg8::StaticOrder S; S.init(T_, D_, G, bx);
      LAS float* fac = (LAS float*)(lds + 128 * 1024);
      { const float* ssqa = (const float*)(ws + WS_SSQA); const float* ssqy = (const float*)(ws + WS_SSQY); pg8::Unit uu;
        if (threadIdx.x < 4) ((LAS int*)(fac + 4 * 768))[threadIdx.x] = -1;
        __syncthreads();
        for (int i = 0, nsl = 0, lastpm = -1; i < 16 && S.next(i, uu); ++i) { if (uu.pm == lastpm || nsl >= 4) continue; lastpm = uu.pm;
            if (threadIdx.x < 256) { const int row = uu.pm * 256 + threadIdx.x;
                const float sa = 1.0f / sqrtf(ssqa[row] * (1.0f / 512.0f) + EPS), s0 = 1.0f / sqrtf(ssqy[2 * row] * (1.0f / 256.0f) + EPS), s1 = 1.0f / sqrtf(ssqy[2 * row + 1] * (1.0f / 256.0f) + EPS);
                fac[nsl * 768 + threadIdx.x] = sa / s0; fac[nsl * 768 + 256 + threadIdx.x] = s0 / s1; fac[nsl * 768 + 512 + threadIdx.x] = s1; }
            if (threadIdx.x == 0) ((LAS int*)(fac + 4 * 768))[nsl] = uu.pm;
            ++nsl; }
        __syncthreads(); }
      pg8::EpiResidMix E{a.x, D_, (bf16*)(ws + WS_X1B), (float*)(ws + WS_SSQ), fac};
      pg8::gemm_phase<pg8::EpiResidMix, pg8::StaticOrder, true, true>(lds, g, S, E); }
    GRID_BAR();
    { pg8::Gemm g{(const bf16*)(ws + WS_X1B), (const bf16*)(ws + WS_WUP), T_, FF, D_, D_}; pg8::StaticOrder S; S.init(T_, FF, G, bx);
      pg8::EpiBf16<1> E{(bf16*)(ws + WS_U), FF, (float*)(ws + WS_SSQ)};
      pg8::gemm_phase<pg8::EpiBf16<1>, pg8::StaticOrder, true, true>(lds, g, S, E); }
    GRID_BAR();
    { pg8::Gemm g{(const bf16*)(ws + WS_U), (const bf16*)(ws + WS_WDN), T_, D_, FF, FF}; pg8::StaticOrder S; S.init(T_, D_, G, bx);
      pg8::EpiResid<false> E{nullptr, a.out, D_, (bf16*)(ws + WS_X1B), nullptr};
      pg8::gemm_phase<pg8::EpiResid<false>, pg8::StaticOrder, true, true>(lds, g, S, E); }
}

extern "C" void kernel_launch(void* const* d_in, const int* in_sizes, int n_in, void* d_out, int out_size, void* d_ws, size_t ws_size, hipStream_t stream) {
    static int grid = 0;
    if (grid == 0) {
        int dev = 0, cus = 0, per_cu = 0;
        hipGetDevice(&dev);
        hipDeviceGetAttribute(&cus, hipDeviceAttributeMultiprocessorCount, dev);
        if (hipFuncSetAttribute((const void*)fwd_megakernel, hipFuncAttributeMaxDynamicSharedMemorySize, LDS_BYTES) != hipSuccess) fprintf(stderr, "hipFuncSetAttribute failed\n");
        if (hipOccupancyMaxActiveBlocksPerMultiprocessor(&per_cu, (const void*)fwd_megakernel, NTHREADS, LDS_BYTES) != hipSuccess || per_cu < 1) { fprintf(stderr, "occupancy query: %d\n", per_cu); per_cu = 1; }
        (void)hipGetLastError();
        grid = cus * (per_cu > 1 ? 1 : per_cu);
        if (ws_size < 256 * MB) fprintf(stderr, "workspace too small: %zu\n", ws_size);
    }
    Args a{};
    a.x = (const float*)d_in[0]; a.pos = (const int*)d_in[1]; a.ln_mix_g = (const float*)d_in[2]; a.w_in = (const float*)d_in[3]; a.q_a_g = (const float*)d_in[4]; a.w_uq = (const float*)d_in[5];
    a.kv_a_g = (const float*)d_in[6]; a.w_ukv = (const float*)d_in[7]; a.q_norm_g = (const float*)d_in[8]; a.k_norm_g = (const float*)d_in[9]; a.attn_out_g = (const float*)d_in[10];
    a.conv_w = (const float*)d_in[11]; a.conv_b = (const float*)d_in[12]; a.a_log_f = (const float*)d_in[13]; a.a_log_b = (const float*)d_in[14]; a.dt_bias_f = (const float*)d_in[15];
    a.dt_bias_b = (const float*)d_in[16]; a.d_skip = (const float*)d_in[17]; a.ssm_norm_g = (const float*)d_in[18]; a.w_out = (const float*)d_in[19]; a.ln_mlp_g = (const float*)d_in[20];
    a.w_up = (const float*)d_in[21]; a.w_dn = (const float*)d_in[22]; a.out = (float*)d_out; a.ws = (unsigned char*)d_ws;
    (void)hipMemsetAsync((char*)d_ws + WS_BAR, 0, (XCD_BAR_WORDS + 128) * 4, stream);
    void* args[] = {&a};
    hipError_t e = hipLaunchCooperativeKernel((const void*)fwd_megakernel, dim3(grid), dim3(NTHREADS), args, LDS_BYTES, stream);
    if (e != hipSuccess) fprintf(stderr, "cooperative launch failed: %s (grid %d)\n", hipGetErrorString(e), grid);
}
```

```cpp
#include <hip/hip_runtime.h>
#include <hip/hip_cooperative_groups.h>
#include <cstdio>
#include <cstdint>
namespace cg = cooperative_groups;
__device__ __forceinline__ int opaque_tid() { int t = threadIdx.x; asm volatile("" : "+v"(t)); return t; }

namespace pg8 {
#define PG8_LAS __attribute__((address_space(3)))
typedef unsigned short bf16_t;
typedef short bf16x8 __attribute__((ext_vector_type(8)));
typedef float f32x4 __attribute__((ext_vector_type(4)));
typedef unsigned u32x4 __attribute__((ext_vector_type(4)));
constexpr int BM = 256, BK = 64, HALF = 128, HTB = HALF * BK * 2  , STAGE_BYTES = 8 * HTB, NXCD = 8, WGM = 4;

__host__ __device__ __forceinline__ int lds_byte(int r, int c) { const int st = (r >> 4) * 2 + (c >> 5), rr = r & 15, cc = c & 31, ob = rr * 64 + cc * 2; return st * 1024 + (ob ^ (((ob >> 9) & 1) << 5)); }
__host__ __device__ __forceinline__ void stage_rc(int b, int& R, int& C) { const int st = b / 1024, sb = b % 1024, swz = sb ^ (((sb >> 9) & 1) << 5); R = (st >> 1) * 16 + swz / 64; C = (st & 1) * 32 + (swz % 64) / 2; }
__host__ __device__ __forceinline__ int perm32(int rho) { const int n = rho >> 4, i = rho & 15; return 8 * (i >> 2) + 4 * n + (i & 3); }

struct Unit { int pm, pn; };
struct Gemm { const bf16_t* A; const bf16_t* Bt; int M, N, K, lda; };

struct StaticOrder {
    int nM, nN, nwg, G, c;
    __host__ __device__ void init(int M, int N, int G_, int c_) { nM = M / BM; nN = N / BM; nwg = nM * nN; G = G_; c = c_; }
    __host__ __device__ bool next(int i, Unit& u) const {
        const long L = (long)i * G + c; if (L >= nwg) return false;
        int wgid = (int)L; { const int q = nwg / NXCD, r = nwg % NXCD, xcd = wgid % NXCD, off = wgid / NXCD; wgid = (xcd < r ? xcd * (q + 1) : r * (q + 1) + (xcd - r) * q) + off; }
        const int nig = WGM * nN, gid = wgid / nig, fm = gid * WGM, gsz = (nM - fm) < WGM ? (nM - fm) : WGM;
        u.pm = fm + ((wgid % nig) % gsz); u.pn = (wgid % nig) / gsz; return true;
    }
    __device__ __forceinline__ void a_ready(const Unit&) const {}
    __device__ __forceinline__ void done(const Unit&) const {}
};

__device__ __forceinline__ unsigned cvt_pk_bf16(float lo, float hi) { unsigned r; asm volatile("v_cvt_pk_bf16_f32 %0, %1, %2" : "=v"(r) : "v"(lo), "v"(hi)); return r; }
typedef float f32x2 __attribute__((ext_vector_type(2)));

template <int MODE> struct EpiBf16 {
    static constexpr bool PERM = true, AFTER_DRAIN = false, KHOOK = false;
    bf16_t* O; int ldc; float* side;
    __device__ __forceinline__ void operator()(const f32x4 (&acc)[2][2][4][2], const Unit& u, int wr, int wc, int fr, int fq) const {
        const int row0 = u.pm * BM + wr * 64 + fr; const int col0 = u.pn * BM + wc * 32 + 8 * fq;
        float rsv[2][4];
#pragma unroll
        for (int ai = 0; ai < 2; ++ai)
#pragma unroll
            for (int m = 0; m < 4; ++m) rsv[ai][m] = (MODE == 1) ? side[row0 + ai * HALF + m * 16] : 0.f;
#pragma unroll
        for (int ai = 0; ai < 2; ++ai)
#pragma unroll
            for (int m = 0; m < 4; ++m) { const int row = row0 + ai * HALF + m * 16; bf16_t* rowp = O + (size_t)row * ldc + col0;
                float rs = 1.f; if (MODE == 1) rs = 1.0f / sqrtf(rsv[ai][m] * (1.0f / 1024.0f) + 1e-6f);
#pragma unroll
                for (int bj = 0; bj < 2; ++bj) { f32x4 v0 = acc[ai][bj][m][0], v1 = acc[ai][bj][m][1];
                    if (MODE == 1) {
#pragma unroll
                        for (int e = 0; e < 4; ++e) { float a = v0[e] > 0.f ? v0[e] * rs : 0.f; v0[e] = a * a; float b = v1[e] > 0.f ? v1[e] * rs : 0.f; v1[e] = b * b; } }
                    if (MODE == 2) { if (u.pn == 7 && bj == 1 && wc == 1 && fq < 2) { float* sp = side + (size_t)row * 16 + 8 * fq; *(f32x4*)sp = v0; *(f32x4*)(sp + 4) = v1; } }
                    u32x4 w; w.x = cvt_pk_bf16(v0[0], v0[1]); w.y = cvt_pk_bf16(v0[2], v0[3]); w.z = cvt_pk_bf16(v1[0], v1[1]); w.w = cvt_pk_bf16(v1[2], v1[3]);
                    *(u32x4*)(rowp + bj * HALF) = w; } }
    }
};
template <bool STATS> struct EpiResid {
    static constexpr bool PERM = true, AFTER_DRAIN = false, KHOOK = false;
    const float* base; float* out; int ldc; bf16_t* xb; float* ssq;
    __device__ __forceinline__ void operator()(const f32x4 (&acc)[2][2][4][2], const Unit& u, int wr, int wc, int fr, int fq) const {
        const int row0 = u.pm * BM + wr * 64 + fr; const int col0 = u.pn * BM + wc * 32 + 8 * fq;
#pragma unroll
        for (int ai = 0; ai < 2; ++ai) {
            f32x4 b0[4][2], b1[4][2]; u32x4 wx[4][2];
#pragma unroll
            for (int m = 0; m < 4; ++m)
#pragma unroll
                for (int bj = 0; bj < 2; ++bj) { const size_t o = (size_t)(row0 + ai * HALF + m * 16) * ldc + col0 + bj * HALF;
                    if (STATS) { b0[m][bj] = *(const f32x4*)(base + o); b1[m][bj] = *(const f32x4*)(base + o + 4); } else wx[m][bj] = *(const u32x4*)(xb + o); }
#pragma unroll
            for (int m = 0; m < 4; ++m) { const int row = row0 + ai * HALF + m * 16; const size_t ro = (size_t)row * ldc + col0; float sq = 0.f;
#pragma unroll
                for (int bj = 0; bj < 2; ++bj) { const size_t o = ro + bj * HALF;
                    if (STATS) {
                        const f32x4 v0 = b0[m][bj] + acc[ai][bj][m][0], v1 = b1[m][bj] + acc[ai][bj][m][1];
                        u32x4 w; w.x = cvt_pk_bf16(v0[0], v0[1]); w.y = cvt_pk_bf16(v0[2], v0[3]); w.z = cvt_pk_bf16(v1[0], v1[1]); w.w = cvt_pk_bf16(v1[2], v1[3]); *(u32x4*)(xb + o) = w;
                        sq += (v0[0] * v0[0] + v0[1] * v0[1]) + (v0[2] * v0[2] + v0[3] * v0[3]) + (v1[0] * v1[0] + v1[1] * v1[1]) + (v1[2] * v1[2] + v1[3] * v1[3]);
                    } else {
                        const u32x4 w = wx[m][bj];
                        f32x4 c0, c1; c0[0] = __builtin_bit_cast(float, w.x << 16); c0[1] = __builtin_bit_cast(float, w.x & 0xffff0000u); c0[2] = __builtin_bit_cast(float, w.y << 16); c0[3] = __builtin_bit_cast(float, w.y & 0xffff0000u);
                        c1[0] = __builtin_bit_cast(float, w.z << 16); c1[1] = __builtin_bit_cast(float, w.z & 0xffff0000u); c1[2] = __builtin_bit_cast(float, w.w << 16); c1[3] = __builtin_bit_cast(float, w.w & 0xffff0000u);
                        *(f32x4*)(out + o) = c0 + acc[ai][bj][m][0]; *(f32x4*)(out + o + 4) = c1 + acc[ai][bj][m][1];
                    } }
                if (STATS) { sq += __shfl_xor(sq, 16); sq += __shfl_xor(sq, 32); if (fq == 0) atomicAdd(ssq + row, sq); } }
        }
    }
};

struct EpiResidMix {
    static constexpr bool PERM = true, AFTER_DRAIN = false, KHOOK = true;
    const float* base; int ldc; bf16_t* xb; float* ssq;
    const PG8_LAS float* fac;
    __device__ __forceinline__ int slot_of(const Unit& u) const { const PG8_LAS int* pms = (const PG8_LAS int*)(fac + 4 * 768); int sl = 0;
#pragma unroll
        for (int i = 1; i < 4; ++i) if (pms[i] == u.pm) sl = i;
        return sl; }
    __device__ __forceinline__ void khook(f32x4 (&acc)[2][2][4][2], const Unit& u, int t, int wr, int fr) const {
        const PG8_LAS float* f = fac + slot_of(u) * 768 + (t == 8 ? 0 : 256) + wr * 64 + fr;
#pragma unroll
        for (int ai = 0; ai < 2; ++ai)
#pragma unroll
            for (int m = 0; m < 4; ++m) { const float sc = f[ai * HALF + m * 16];
#pragma unroll
                for (int bj = 0; bj < 2; ++bj)
#pragma unroll
                    for (int n = 0; n < 2; ++n) acc[ai][bj][m][n] = acc[ai][bj][m][n] * sc; }
    }
    __device__ __forceinline__ void operator()(const f32x4 (&acc)[2][2][4][2], const Unit& u, int wr, int wc, int fr, int fq) const {
        const int row0 = u.pm * BM + wr * 64 + fr; const int col0 = u.pn * BM + wc * 32 + 8 * fq;
        const PG8_LAS float* f = fac + slot_of(u) * 768 + 512 + wr * 64 + fr;
#pragma unroll
        for (int ai = 0; ai < 2; ++ai) {
            f32x4 b0[4][2], b1[4][2]; float fs[4];
#pragma unroll
            for (int m = 0; m < 4; ++m) { fs[m] = f[ai * HALF + m * 16];
#pragma unroll
                for (int bj = 0; bj < 2; ++bj) { const size_t o = (size_t)(row0 + ai * HALF + m * 16) * ldc + col0 + bj * HALF; b0[m][bj] = *(const f32x4*)(base + o); b1[m][bj] = *(const f32x4*)(base + o + 4); } }
#pragma unroll
            for (int m = 0; m < 4; ++m) { const int row = row0 + ai * HALF + m * 16; const size_t ro = (size_t)row * ldc + col0; float sq = 0.f;
#pragma unroll
                for (int bj = 0; bj < 2; ++bj) { const size_t o = ro + bj * HALF;
                    const f32x4 v0 = b0[m][bj] + acc[ai][bj][m][0] * fs[m], v1 = b1[m][bj] + acc[ai][bj][m][1] * fs[m];
                    u32x4 w; w.x = cvt_pk_bf16(v0[0], v0[1]); w.y = cvt_pk_bf16(v0[2], v0[3]); w.z = cvt_pk_bf16(v1[0], v1[1]); w.w = cvt_pk_bf16(v1[2], v1[3]); *(u32x4*)(xb + o) = w;
                    sq += (v0[0] * v0[0] + v0[1] * v0[1]) + (v0[2] * v0[2] + v0[3] * v0[3]) + (v1[0] * v1[0] + v1[1] * v1[1]) + (v1[2] * v1[2] + v1[3] * v1[3]); }
                sq += __shfl_xor(sq, 16); sq += __shfl_xor(sq, 32); if (fq == 0) atomicAdd(ssq + row, sq); }
        }
    }
};

template <class Epi, class Sched, bool ALIGN_EPI = false, bool SP2 = false>
__device__ __forceinline__ void gemm_phase(PG8_LAS unsigned char* lds, const Gemm g, const Sched& S, const Epi& E) {
    const int tid = opaque_tid(), wid = __builtin_amdgcn_readfirstlane(tid >> 6), lane = tid & 63, wr = wid >> 2, wc = wid & 3, fr = lane & 15, fq = lane >> 4;
    int K = g.K; asm volatile("" : "+s"(K));
    const int nt = K / BK;
    unsigned voffA[2], voffB[2];
#pragma unroll
    for (int i = 0; i < 2; ++i) { int R, C; stage_rc(tid * 16 + i * 8192, R, C); const int Rb = Epi::PERM ? ((R & ~31) + perm32(R & 31)) : R;
        voffA[i] = (unsigned)(R * g.lda + C) * 2u; voffB[i] = (unsigned)(Rb * K + C) * 2u; }
    const size_t kstep = (size_t)(BK * 2);
    const size_t hstepB = (size_t)HALF * K * 2, hstepA = (size_t)HALF * g.lda * 2;
    const size_t tstepB = 2 * hstepB, tstepA = 2 * hstepA;
    const unsigned ldsw = (unsigned)wid * 1024u;
    const int aoff = lds_byte(wr * 64 + fr, fq * 8), boff = lds_byte(wc * 32 + fr, fq * 8);
#define PG8_SA(b, h) (((b) * 2 + (h)) * HTB)
#define PG8_SB(b, h) ((4 + (b) * 2 + (h)) * HTB)
#define PG8_STAGE(bufoff, gbase, voff) do { _Pragma("unroll") for (int _i = 0; _i < 2; ++_i) \
        __builtin_amdgcn_global_load_lds((const unsigned*)((const char*)(gbase) + (voff)[_i]), (PG8_LAS unsigned*)(lds + (bufoff) + ldsw + _i * 8192), 16, 0, 0); } while (0)
#define PG8_LDA(dst, b, h) do { _Pragma("unroll") for (int m = 0; m < 4; ++m) _Pragma("unroll") for (int k = 0; k < 2; ++k) dst[m][k] = *(const PG8_LAS bf16x8*)(lds + PG8_SA(b, h) + aoff + m * 2048 + k * 1024); } while (0)
#define PG8_LDB(dst, b, h) do { _Pragma("unroll") for (int n = 0; n < 2; ++n) _Pragma("unroll") for (int k = 0; k < 2; ++k) dst[n][k] = *(const PG8_LAS bf16x8*)(lds + PG8_SB(b, h) + boff + n * 2048 + k * 1024); } while (0)
#define PG8_MMA(ai, bj, At, Bt) do { __builtin_amdgcn_s_setprio(1); _Pragma("unroll") for (int m = 0; m < 4; ++m) _Pragma("unroll") for (int n = 0; n < 2; ++n) _Pragma("unroll") for (int k = 0; k < 2; ++k) \
        acc[ai][bj][m][n] = __builtin_amdgcn_mfma_f32_16x16x32_bf16(Bt[n][k], At[m][k], acc[ai][bj][m][n], 0, 0, 0); __builtin_amdgcn_s_setprio(0); } while (0)
#define PG8_WAIT_V(n) asm volatile("s_waitcnt vmcnt(" #n ")" ::: "memory")
#define PG8_WAIT_L(n) asm volatile("s_waitcnt lgkmcnt(" #n ")" ::: "memory")
#define PG8_BAR __builtin_amdgcn_s_barrier()
#define PG8_SCHED __builtin_amdgcn_sched_barrier(0)
    Unit cur, nxt; int ui = 0;
    if (!S.next(0, cur)) return;
    f32x4 acc[2][2][4][2];
#pragma unroll
    for (int a = 0; a < 2; ++a)
#pragma unroll
        for (int b = 0; b < 2; ++b)
#pragma unroll
            for (int m = 0; m < 4; ++m)
#pragma unroll
                for (int n = 0; n < 2; ++n) acc[a][b][m][n] = (f32x4){0.f, 0.f, 0.f, 0.f};
    bf16x8 At[4][2], B0[2][2], B1[2][2];
    const char* cA = (const char*)g.A + (size_t)cur.pm * tstepA; const char* cB = (const char*)g.Bt + (size_t)cur.pn * tstepB;
    S.a_ready(cur);
    if constexpr (SP2) {
        PG8_STAGE(PG8_SB(0, 0), cB, voffB); PG8_STAGE(PG8_SB(0, 1), cB + hstepB, voffB); PG8_STAGE(PG8_SA(0, 0), cA, voffA); PG8_STAGE(PG8_SA(0, 1), cA + hstepA, voffA);
        if (wr == 1) PG8_BAR;
        PG8_WAIT_V(2); PG8_BAR;
        PG8_STAGE(PG8_SB(1, 0), cB + kstep, voffB); PG8_STAGE(PG8_SA(1, 0), cA + kstep, voffA); PG8_STAGE(PG8_SB(1, 1), cB + hstepB + kstep, voffB);
        PG8_WAIT_V(6); PG8_BAR;
    } else {
        PG8_STAGE(PG8_SB(0, 0), cB, voffB); PG8_STAGE(PG8_SA(0, 0), cA, voffA); PG8_STAGE(PG8_SB(0, 1), cB + hstepB, voffB); PG8_STAGE(PG8_SA(0, 1), cA + hstepA, voffA);
        if (wr == 1) PG8_BAR;
        PG8_WAIT_V(4); PG8_BAR;
        PG8_STAGE(PG8_SB(1, 0), cB + kstep, voffB); PG8_STAGE(PG8_SA(1, 0), cA + kstep, voffA); PG8_STAGE(PG8_SB(1, 1), cB + hstepB + kstep, voffB);
        PG8_WAIT_V(6); PG8_BAR;
    }
    for (;;) {
        const bool has_next = S.next(ui + 1, nxt);
        const char* nA = has_next ? (const char*)g.A + (size_t)nxt.pm * tstepA : cA; const char* nB = has_next ? (const char*)g.Bt + (size_t)nxt.pn * tstepB : cB;
        for (int t = 0; t < nt; t += 2) {
            if constexpr (Epi::KHOOK) { if (t == 8 || t == 12) E.khook(acc, cur, t, wr, fr); }
            const bool last = (t == nt - 2);
            const char* a1 = cA + (size_t)(t + 1) * kstep;
            const char* a2 = last ? nA : cA + (size_t)(t + 2) * kstep; const char* b2 = last ? nB : cB + (size_t)(t + 2) * kstep;
            const char* a3 = a2 + kstep; const char* b3 = b2 + kstep;
            if (last && has_next) S.a_ready(nxt);
            if constexpr (SP2) {
            PG8_LDB(B0, 0, 0); PG8_LDB(B1, 0, 1); PG8_SCHED; PG8_LDA(At, 0, 0); PG8_STAGE(PG8_SA(1, 1), a1 + hstepA, voffA);
            PG8_WAIT_V(8); PG8_WAIT_L(0); PG8_BAR; PG8_MMA(0, 0, At, B0); PG8_MMA(0, 1, At, B1); PG8_BAR; PG8_SCHED;
            PG8_LDA(At, 0, 1); PG8_STAGE(PG8_SB(0, 0), b2, voffB); PG8_STAGE(PG8_SB(0, 1), b2 + hstepB, voffB); PG8_STAGE(PG8_SA(0, 0), a2, voffA);
            PG8_WAIT_V(8); PG8_WAIT_L(0); PG8_BAR; PG8_MMA(1, 0, At, B0); PG8_MMA(1, 1, At, B1); PG8_BAR; PG8_SCHED;
            PG8_LDB(B0, 1, 0); PG8_LDB(B1, 1, 1); PG8_SCHED; PG8_LDA(At, 1, 0); PG8_STAGE(PG8_SA(0, 1), a2 + hstepA, voffA);
            PG8_WAIT_V(8); PG8_WAIT_L(0); PG8_BAR; PG8_MMA(0, 0, At, B0); PG8_MMA(0, 1, At, B1); PG8_BAR; PG8_SCHED;
            PG8_LDA(At, 1, 1); PG8_STAGE(PG8_SB(1, 0), b3, voffB); PG8_STAGE(PG8_SB(1, 1), b3 + hstepB, voffB); PG8_STAGE(PG8_SA(1, 0), a3, voffA);
            PG8_WAIT_V(8); PG8_WAIT_L(0); PG8_BAR; PG8_MMA(1, 0, At, B0); PG8_MMA(1, 1, At, B1); PG8_BAR; PG8_SCHED;
            } else {
            PG8_LDB(B0, 0, 0); PG8_SCHED; PG8_LDA(At, 0, 0); PG8_STAGE(PG8_SA(1, 1), a1 + hstepA, voffA);
            PG8_WAIT_L(8); PG8_BAR; PG8_WAIT_L(0); PG8_MMA(0, 0, At, B0); PG8_BAR; PG8_SCHED;
            PG8_LDB(B1, 0, 1); PG8_STAGE(PG8_SB(0, 0), b2, voffB);
            PG8_BAR; PG8_WAIT_L(0); PG8_MMA(0, 1, At, B1); PG8_BAR;
            PG8_LDA(At, 0, 1); PG8_STAGE(PG8_SA(0, 0), a2, voffA);
            PG8_BAR; PG8_WAIT_L(0); PG8_MMA(1, 0, At, B0); PG8_BAR; PG8_SCHED;
            PG8_STAGE(PG8_SB(0, 1), b2 + hstepB, voffB);
            PG8_WAIT_V(6); PG8_BAR; PG8_MMA(1, 1, At, B1); PG8_BAR;
            PG8_LDB(B0, 1, 0); PG8_SCHED; PG8_LDA(At, 1, 0); PG8_STAGE(PG8_SA(0, 1), a2 + hstepA, voffA);
            PG8_WAIT_L(8); PG8_BAR; PG8_WAIT_L(0); PG8_MMA(0, 0, At, B0); PG8_BAR; PG8_SCHED;
            PG8_LDB(B1, 1, 1); PG8_STAGE(PG8_SB(1, 0), b3, voffB);
            PG8_BAR; PG8_WAIT_L(0); PG8_MMA(0, 1, At, B1); PG8_BAR;
            PG8_LDA(At, 1, 1); PG8_STAGE(PG8_SA(1, 0), a3, voffA);
            PG8_BAR; PG8_WAIT_L(0); PG8_MMA(1, 0, At, B0); PG8_BAR; PG8_SCHED;
            PG8_STAGE(PG8_SB(1, 1), b3 + hstepB, voffB);
            PG8_WAIT_V(6); PG8_BAR; PG8_MMA(1, 1, At, B1); PG8_BAR;
            }
        }
        if constexpr (ALIGN_EPI) { if (wr == 0) PG8_BAR; }
        if constexpr (!Epi::AFTER_DRAIN) { E(acc, cur, wr, wc, fr, fq); S.done(cur); }
        if (!has_next) break;
#pragma unroll
        for (int a = 0; a < 2; ++a)
#pragma unroll
            for (int b = 0; b < 2; ++b)
#pragma unroll
                for (int m = 0; m < 4; ++m)
#pragma unroll
                    for (int n = 0; n < 2; ++n) acc[a][b][m][n] = (f32x4){0.f, 0.f, 0.f, 0.f};
        cur = nxt; cA = nA; cB = nB; ++ui;
        if constexpr (ALIGN_EPI) { if (wr == 1) PG8_BAR; }
    }
    PG8_WAIT_V(0);
    if constexpr (!ALIGN_EPI) { if (wr == 0) PG8_BAR; }
    PG8_BAR;
    if constexpr (Epi::AFTER_DRAIN) { E.fused(acc, cur, wr, wc, fr, fq, lds, wid, lane); S.done(cur); }
#undef PG8_SA
#undef PG8_SB
#undef PG8_STAGE
#undef PG8_LDA
#undef PG8_LDB
#undef PG8_MMA
#undef PG8_WAIT_V
#undef PG8_WAIT_L
#undef PG8_BAR
#undef PG8_SCHED
}
}
#define LAS __attribute__((address_space(3)))
typedef unsigned short bf16;
typedef float f32x4 __attribute__((ext_vector_type(4)));
typedef float f32x2 __attribute__((ext_vector_type(2)));
typedef float f32x16 __attribute__((ext_vector_type(16)));
typedef short bf16x8 __attribute__((ext_vector_type(8)));
typedef short s16x4 __attribute__((ext_vector_type(4)));
typedef unsigned u32x4 __attribute__((ext_vector_type(4)));
typedef unsigned u32x2 __attribute__((ext_vector_type(2)));
typedef __bf16 bf16x2_t __attribute__((ext_vector_type(2)));
#define MFMA32(a, b, c) __builtin_amdgcn_mfma_f32_32x32x16_bf16((a), (b), (c), 0, 0, 0)

constexpr int NB = 8, S_ = 2048, T_ = NB * S_, D_ = 1024, NPROJ = 2048, INW = 1968, FF = 4096;
constexpr int NWAVES = 8, NTHREADS = 512;
constexpr int LDS_BYTES = 144 * 1024;
constexpr float EPS = 1e-6f;
constexpr float LOG2E = 1.4426950408889634f;
constexpr int C_CQ = 0, C_CKV = 256, C_KPE = 384, C_Z = 416, C_XBC = 928, C_DT = 1952;
constexpr size_t MB = 1024 * 1024;
constexpr size_t WS_PROJ = 0, WS_QRAW = 64 * MB, WS_KVRAW = 88 * MB, WS_VEC = 120 * MB, WS_DTRAW = 124 * MB;
constexpr size_t WS_ATTNO = 64 * MB, WS_YG = 88 * MB, WS_U = 0;
constexpr size_t WS_HB = 128 * MB;
constexpr size_t WS_BT = WS_HB + 24 * MB;
constexpr size_t HST_OFF = (size_t)8 * 1024 * 1024;
constexpr size_t WS_K = 160 * MB, WS_VT = 184 * MB, WS_BM = 200 * MB, WS_CM = 208 * MB, WS_XT = 216 * MB;
constexpr size_t WS_WIN = 232 * MB, WS_WUQ = 236 * MB, WS_WUKV = WS_WUQ + 768 * 256 * 2, WS_WOUT = WS_WUKV + 1024 * 128 * 2, WS_WUP = WS_WOUT + 2 * MB, WS_WDN = WS_WUP + 8 * MB;
constexpr size_t WS_MIXRAW = 64 * MB;
constexpr size_t WS_SSQA = 255 * MB + 64 * 1024, WS_SSQY = 255 * MB + 128 * 1024;
constexpr size_t WS_BAR = 255 * MB + 256 * 1024;
constexpr int MISC_OFF = 140 * 1024;
constexpr size_t WS_SSQ = 255 * MB, WS_X1B = WS_K;
static_assert(WS_WDN + 8 * MB <= WS_SSQ, "ws map");

struct Args {
    const float* x; const int* pos; const float* ln_mix_g; const float* w_in; const float* q_a_g; const float* w_uq; const float* kv_a_g; const float* w_ukv;
    const float* q_norm_g; const float* k_norm_g; const float* attn_out_g; const float* conv_w; const float* conv_b; const float* a_log_f; const float* a_log_b;
    const float* dt_bias_f; const float* dt_bias_b; const float* d_skip; const float* ssm_norm_g; const float* w_out; const float* ln_mlp_g; const float* w_up; const float* w_dn;
    float* out; unsigned char* ws;
};

__device__ __forceinline__ unsigned f2bf(float f) { unsigned u = __builtin_bit_cast(unsigned, f); return (u + 0x7fffu + ((u >> 16) & 1u)) >> 16; }
__device__ __forceinline__ unsigned pk2(float lo, float hi) { f32x2 v = {lo, hi}; bf16x2_t b = __builtin_convertvector(v, bf16x2_t); return __builtin_bit_cast(unsigned, b); }
__device__ __forceinline__ float bf2f(unsigned short b) { return __builtin_bit_cast(float, (unsigned)b << 16); }
__device__ __forceinline__ float bflo(unsigned w) { return __builtin_bit_cast(float, w << 16); }
__device__ __forceinline__ float bfhi(unsigned w) { return __builtin_bit_cast(float, w & 0xffff0000u); }
__device__ __forceinline__ float wave_sum(float v) {
#pragma unroll
    for (int o = 1; o < 64; o <<= 1) v += __shfl_xor(v, o);
    return v;
}
__device__ __forceinline__ float ex2(float x) { return __builtin_amdgcn_exp2f(x); }
__device__ __forceinline__ float silu(float z) { return z / (1.f + __expf(-z)); }

__device__ __forceinline__ void transpose_item(const float* W, int K, int N, bf16* WT, const float* gain, LAS float* scr, int item, int nblk, int lane) {
    const int kb = item / nblk, nb = item % nblk, k0 = 64 * kb, n0 = 64 * nb;
    const int kr = lane >> 4, nc = 4 * (lane & 15);
    const bool ok = (n0 + nc) < N;
    f32x4 v[16];
#pragma unroll
    for (int i = 0; i < 16; ++i) { v[i] = (f32x4){0.f, 0.f, 0.f, 0.f}; if (ok) v[i] = *(const f32x4*)(W + (size_t)(k0 + 4 * i + kr) * N + n0 + nc); }
    if (gain) {
#pragma unroll
        for (int i = 0; i < 16; ++i) v[i] = v[i] * gain[k0 + 4 * i + kr]; }
#pragma unroll
    for (int i = 0; i < 16; ++i) { LAS float* d = scr + (4 * i + kr) * 65 + nc; d[0] = v[i].x; d[1] = v[i].y; d[2] = v[i].z; d[3] = v[i].w; }
    asm volatile("s_waitcnt lgkmcnt(0)" ::: "memory");
    const int c = lane & 7;
#pragma unroll
    for (int j = 0; j < 8; ++j) { const int n = (lane >> 3) + 8 * j; const LAS float* sp = scr + (8 * c) * 65 + n;
        u32x4 o; o.x = pk2(sp[0 * 65], sp[1 * 65]); o.y = pk2(sp[2 * 65], sp[3 * 65]); o.z = pk2(sp[4 * 65], sp[5 * 65]); o.w = pk2(sp[6 * 65], sp[7 * 65]);
        *(u32x4*)(WT + (size_t)(n0 + n) * K + k0 + 8 * c) = o; }
    asm volatile("s_waitcnt lgkmcnt(0)" ::: "memory");
}
__device__ __forceinline__ void rms_row_to_bf16(const float* xrow, const float* g, bf16* orow, int lane) {
    const f32x4* xr = (const f32x4*)xrow + lane; const f32x4* gr = (const f32x4*)g + lane;
    f32x4 v[4]; float s = 0.f;
#pragma unroll
    for (int j = 0; j < 4; ++j) { v[j] = xr[64 * j]; s += (v[j].x * v[j].x + v[j].y * v[j].y) + (v[j].z * v[j].z + v[j].w * v[j].w); }
    const float rstd = 1.f / sqrtf(wave_sum(s) * (1.f / D_) + EPS);
    u32x2* o8 = (u32x2*)orow + lane;
#pragma unroll
    for (int j = 0; j < 4; ++j) { const f32x4 gg = gr[64 * j]; u32x2 o; o.x = pk2(v[j].x * rstd * gg.x, v[j].y * rstd * gg.y); o.y = pk2(v[j].z * rstd * gg.z, v[j].w * rstd * gg.w); o8[64 * j] = o; }
}
__device__ __forceinline__ void p0_prologue(const Args& a, LAS unsigned char* lds) {
    const int tid = opaque_tid(), lane = tid & 63, wave = tid >> 6;
    LAS float* scr = (LAS float*)(lds + wave * 16640);
    const int gw = blockIdx.x * NWAVES + wave, NGW = gridDim.x * NWAVES;
    constexpr int I_IN = (D_ / 64) * (NPROJ / 64), I_UQ = (256 / 64) * (768 / 64), I_UKV = (128 / 64) * (1024 / 64), I_OUT = (D_ / 64) * (D_ / 64), I_UP = (D_ / 64) * (FF / 64), I_DN = (FF / 64) * (D_ / 64);
    constexpr int NITEMS = I_IN + I_UQ + I_UKV + I_OUT + I_UP + I_DN;
    unsigned char* ws = a.ws;
    for (int it = gw; it < I_IN + I_UQ + I_UKV + I_OUT; it += NGW) {
        int r = it;
        if (r < I_IN) { transpose_item(a.w_in, D_, INW, (bf16*)(ws + WS_WIN), nullptr, scr, r, NPROJ / 64, lane); continue; } r -= I_IN;
        if (r < I_UQ) { transpose_item(a.w_uq, 256, 768, (bf16*)(ws + WS_WUQ), a.q_a_g, scr, r, 768 / 64, lane); continue; } r -= I_UQ;
        if (r < I_UKV) { transpose_item(a.w_ukv, 128, 1024, (bf16*)(ws + WS_WUKV), a.kv_a_g, scr, r, 1024 / 64, lane); continue; } r -= I_UKV;
        if (r < I_OUT) { transpose_item(a.w_out, D_, D_, (bf16*)(ws + WS_WOUT), (64 * (r / (D_ / 64)) < 512) ? a.attn_out_g : a.ssm_norm_g - 512, scr, r, D_ / 64, lane); continue; } r -= I_OUT;
    }
    bf16* H = (bf16*)(ws + WS_HB);
    for (int m = gw; m < T_; m += NGW) rms_row_to_bf16(a.x + (size_t)m * D_, a.ln_mix_g, H + (size_t)m * D_, lane);
    { float* ssq = (float*)(ws + WS_SSQ); float* sa = (float*)(ws + WS_SSQA); float* sy = (float*)(ws + WS_SSQY);
      for (int i = blockIdx.x * NTHREADS + tid; i < T_; i += gridDim.x * NTHREADS) { ssq[i] = 0.f; sa[i] = 0.f; sy[2 * i] = 0.f; sy[2 * i + 1] = 0.f; } }
}

__device__ __forceinline__ void p0b_mlp_weights(const Args& a, LAS unsigned char* lds) {
    const int tid = opaque_tid(), lane = tid & 63, wave = tid >> 6;
    LAS float* scr = (LAS float*)(lds + wave * 16640);
    const int gw = blockIdx.x * NWAVES + wave, NGW = gridDim.x * NWAVES;
    constexpr int I_UP = (D_ / 64) * (FF / 64), I_DN = (FF / 64) * (D_ / 64);
    for (int it = gw; it < I_UP + I_DN; it += NGW) {
        if (it < I_UP) transpose_item(a.w_up, D_, FF, (bf16*)(a.ws + WS_WUP), a.ln_mlp_g, scr, it, FF / 64, lane);
        else transpose_item(a.w_dn, FF, D_, (bf16*)(a.ws + WS_WDN), nullptr, scr, it - I_UP, D_ / 64, lane);
    }
    __syncthreads();
}

__device__ __forceinline__ void prep_conv(const Args& a, LAS unsigned char* lds) {
    const int tid = opaque_tid(), cg8 = tid & 63, tq = tid >> 6;
    const bf16* proj = (const bf16*)(a.ws + WS_PROJ);
    bf16* Xt = (bf16*)(a.ws + WS_XT); bf16* Bm = (bf16*)(a.ws + WS_BM); bf16* Cm = (bf16*)(a.ws + WS_CM); bf16* Btr = (bf16*)(a.ws + WS_BT);
    LAS bf16* tile = (LAS bf16*)lds;
    for (int item = blockIdx.x; item < NB * 32 * 2; item += gridDim.x) {
        const int half = item & 1, tb = (item >> 1) & 31, b = item >> 6;
        const int ch = half * 512 + cg8 * 8, t0 = tb * 64 + tq * 8;
        u32x4 rows[12];
#pragma unroll
        for (int k = 0; k < 12; ++k) { const int tt = t0 - 2 + k; rows[k] = (u32x4){0u, 0u, 0u, 0u}; if (tt >= 0 && tt < S_) rows[k] = *(const u32x4*)(proj + (size_t)(b * S_ + tt) * NPROJ + C_XBC + ch); }
        f32x2 w2[5][4], b2[4];
#pragma unroll
        for (int j = 0; j < 5; ++j) { const f32x4 w0 = *(const f32x4*)(a.conv_w + j * 1024 + ch), w1 = *(const f32x4*)(a.conv_w + j * 1024 + ch + 4);
            w2[j][0] = (f32x2){w0.x, w0.y}; w2[j][1] = (f32x2){w0.z, w0.w}; w2[j][2] = (f32x2){w1.x, w1.y}; w2[j][3] = (f32x2){w1.z, w1.w}; }
        { const f32x4 b0 = *(const f32x4*)(a.conv_b + ch), b1 = *(const f32x4*)(a.conv_b + ch + 4);
          b2[0] = (f32x2){b0.x, b0.y}; b2[1] = (f32x2){b0.z, b0.w}; b2[2] = (f32x2){b1.x, b1.y}; b2[3] = (f32x2){b1.z, b1.w}; }
        f32x2 xr[12][4];
#pragma unroll
        for (int k = 0; k < 12; ++k) { const u32x4 v = rows[k]; xr[k][0] = (f32x2){bflo(v.x), bfhi(v.x)}; xr[k][1] = (f32x2){bflo(v.y), bfhi(v.y)}; xr[k][2] = (f32x2){bflo(v.z), bfhi(v.z)}; xr[k][3] = (f32x2){bflo(v.w), bfhi(v.w)}; }
        __syncthreads();
#pragma unroll
        for (int i = 0; i < 8; ++i) {
            f32x2 o2[4];
#pragma unroll
            for (int q = 0; q < 4; ++q) o2[q] = b2[q];
#pragma unroll
            for (int j = 0; j < 5; ++j) { o2[0] += w2[j][0] * xr[i + j][0]; o2[1] += w2[j][1] * xr[i + j][1]; o2[2] += w2[j][2] * xr[i + j][2]; o2[3] += w2[j][3] * xr[i + j][3]; }
            unsigned pw[4];
#pragma unroll
            for (int q = 0; q < 4; ++q) { const f32x2 tneg = o2[q] * (-LOG2E); f32x2 d; d.x = __builtin_amdgcn_exp2f(tneg.x); d.y = __builtin_amdgcn_exp2f(tneg.y); d = d + 1.0f;
                f32x2 rc; rc.x = __builtin_amdgcn_rcpf(d.x); rc.y = __builtin_amdgcn_rcpf(d.y); const f32x2 res = o2[q] * rc; pw[q] = pk2(res.x, res.y); }
            if (half == 0) {
#pragma unroll
                for (int q = 0; q < 4; ++q) { tile[(cg8 * 8 + 2 * q) * 66 + tq * 8 + i] = (bf16)(pw[q] & 0xffffu); tile[(cg8 * 8 + 2 * q + 1) * 66 + tq * 8 + i] = (bf16)(pw[q] >> 16); }
            } else {
                const int k = cg8 >> 4, isC = k >> 1, g = k & 1, n = (cg8 & 15) * 8;
                bf16* dst = (isC ? Cm : Bm) + ((size_t)(b * 2 + g) * S_ + t0 + i) * 128 + n;
                *(u32x4*)dst = (u32x4){pw[0], pw[1], pw[2], pw[3]};
                if (cg8 < 32) {
#pragma unroll
                    for (int q = 0; q < 4; ++q) { tile[(cg8 * 8 + 2 * q) * 66 + tq * 8 + i] = (bf16)(pw[q] & 0xffffu); tile[(cg8 * 8 + 2 * q + 1) * 66 + tq * 8 + i] = (bf16)(pw[q] >> 16); } }
            }
        }
        __syncthreads();
        {
            const int c8 = tid & 7;
#pragma unroll
            for (int k = 0; k < 8; ++k) { const int row = (tid >> 3) + 64 * k;
                if (half == 0 || k < 4) {
                    const LAS unsigned* src = (const LAS unsigned*)(tile + row * 66 + c8 * 8);
                    u32x4 o; o.x = src[0]; o.y = src[1]; o.z = src[2]; o.w = src[3];
                    bf16* dst = (half == 0 ? Xt + ((size_t)b * 512 + row) * S_ : Btr + ((size_t)b * 256 + row) * S_) + tb * 64 + 8 * c8;
                    *(u32x4*)dst = o; } }
        }
    }
    __syncthreads();
}
__device__ __forceinline__ float softplus(float v) { return v > 20.f ? v : log1pf(__expf(v)); }
__device__ __forceinline__ void prep_scan(const Args& a, LAS unsigned char* lds) {
    const int tid = opaque_tid(), lane = tid & 63, wave = tid >> 6;
    const float* dtraw = (const float*)(a.ws + WS_DTRAW);
    float* vec = (float*)(a.ws + WS_VEC);
    const size_t VS = (size_t)NB * 8 * S_;
    LAS float* red = (LAS float*)lds;
    for (int item = (int)gridDim.x - 1 - (int)blockIdx.x; item < NB * 8; item += gridDim.x) {
        const int b = item >> 3, hd = item & 7;
        float* vb = vec + ((size_t)b * 8 + hd) * S_;
        const float af_c = -__expf(a.a_log_f[hd]) * LOG2E, ab_c = -__expf(a.a_log_b[hd]) * LOG2E;
        const float bf_ = a.dt_bias_f[hd], bb_ = a.dt_bias_b[hd];
        const int t0 = tid * 4;
        float dtf[4], dtb[4], pf[4], pb[4]; float sf = 0.f, sb = 0.f;
#pragma unroll
        for (int i = 0; i < 4; ++i) { const float* p = dtraw + (size_t)(b * S_ + t0 + i) * 16; dtf[i] = softplus(p[hd] + bf_); dtb[i] = softplus(p[8 + hd] + bb_); }
#pragma unroll
        for (int i = 0; i < 4; ++i) { pb[i] = sb; sf += dtf[i] * af_c; sb += dtb[i] * ab_c; pf[i] = sf; }
        float incf = sf, incb = sb;
#pragma unroll
        for (int o = 1; o < 64; o <<= 1) { const float uf = __shfl_up(incf, o), ub = __shfl_up(incb, o); if (lane >= o) { incf += uf; incb += ub; } }
        __syncthreads();
        if (lane == 63) { red[wave] = incf; red[8 + wave] = incb; }
        __syncthreads();
        float offf = 0.f, offb = 0.f, TOTB = 0.f;
#pragma unroll
        for (int w2 = 0; w2 < 8; ++w2) { const float vf = red[w2], vbb = red[8 + w2]; if (w2 < wave) { offf += vf; offb += vbb; } TOTB += vbb; }
        incf += offf; incb += offb;
        const float afK0 = __shfl(incf, lane | 15);
        const float rbK0 = TOTB - __shfl(incb - sb, lane & ~15);
        const float afK1 = __shfl(incf, 63);
        const float rbK1 = TOTB - __shfl(incb - sb, 0);
        const float basef = incf - sf, baseb = incb - sb;
        f32x4 o_af, o_rb, o_vtf, o_vtb, o_dtf, o_dtb, o_wf, o_wb;
#pragma unroll
        for (int i = 0; i < 4; ++i) { const float af = basef + pf[i], rb = TOTB - (baseb + pb[i]);
            o_af[i] = af; o_rb[i] = rb; o_vtf[i] = ex2(afK0 - af) * dtf[i]; o_vtb[i] = ex2(rbK0 - rb) * dtb[i]; o_dtf[i] = dtf[i]; o_dtb[i] = dtb[i]; o_wf[i] = ex2(afK1 - af) * dtf[i]; o_wb[i] = ex2(rbK1 - rb) * dtb[i]; }
        *(f32x4*)(vb + 0 * VS + t0) = o_af; *(f32x4*)(vb + 1 * VS + t0) = o_rb; *(f32x4*)(vb + 2 * VS + t0) = o_vtf; *(f32x4*)(vb + 3 * VS + t0) = o_vtb;
        *(f32x4*)(vb + 4 * VS + t0) = o_dtf; *(f32x4*)(vb + 5 * VS + t0) = o_dtb;
        *(f32x4*)(vb + 6 * VS + t0) = o_wf; *(f32x4*)(vb + 7 * VS + t0) = o_wb;
    }
    __syncthreads();
}

#define DPPF(oldv, srcv, ctrl, rmask) __builtin_bit_cast(float, __builtin_amdgcn_update_dpp(__builtin_bit_cast(int, (float)(oldv)), __builtin_bit_cast(int, (float)(srcv)), (ctrl), (rmask), 0xF, false))
__device__ __forceinline__ float sum8_dpp(float v) {
    v += DPPF(0.f, v, 0xB1, 0xF); v += DPPF(0.f, v, 0x4E, 0xF); v += DPPF(0.f, v, 0x141, 0xF); return v; }
__device__ __forceinline__ float wave_sum_dpp(float v) {
    v = sum8_dpp(v); v += DPPF(0.f, v, 0x140, 0xF);
    v += DPPF(0.f, v, 0x142, 0xA); v += DPPF(0.f, v, 0x143, 0xC);
    return __builtin_bit_cast(float, __builtin_amdgcn_readlane(__builtin_bit_cast(int, v), 63)); }
__device__ __forceinline__ float xor4_dpp(float x, bool lo) {
    const float a = DPPF(0.f, x, 0x104, 0xF), b = DPPF(0.f, x, 0x114, 0xF); return lo ? a : b; }
__device__ __forceinline__ void sincos_rev(float ang, float& sn, float& cs) {
    const double r = (double)ang * 0.15915494309189533577; const float fr = (float)(r - __builtin_rint(r));
    sn = __builtin_amdgcn_sinf(fr); cs = __builtin_amdgcn_cosf(fr);
}
__device__ __forceinline__ void p3_qkv(const Args& a, LAS unsigned char* lds) {
    const int tid = opaque_tid(), lane = tid & 63, wave = tid >> 6, hd = lane >> 3, sub = lane & 7;
    const bf16* proj = (const bf16*)(a.ws + WS_PROJ); const bf16* qraw = (const bf16*)(a.ws + WS_QRAW); const bf16* kvraw = (const bf16*)(a.ws + WS_KVRAW);
    bf16* Q = (bf16*)(a.ws + WS_HB); bf16* Kk = (bf16*)(a.ws + WS_K); bf16* Vt = (bf16*)(a.ws + WS_VT);
    LAS bf16* vtile = (LAS bf16*)lds;
    const float qscale = 0.10206207261596577f * LOG2E;
    float gq[12], gk[12], ifr[4];
#pragma unroll
    for (int jj = 0; jj < 3; ++jj)
#pragma unroll
        for (int e = 0; e < 4; ++e) { gq[4 * jj + e] = a.q_norm_g[4 * sub + 32 * jj + e] * qscale; gk[4 * jj + e] = a.k_norm_g[4 * sub + 32 * jj + e]; }
#pragma unroll
    for (int e = 0; e < 4; ++e) ifr[e] = exp2f(-(float)(2 * (4 * (sub & 3) + e)) * (13.287712379549449f / 32.f));
    const float sgn = (sub < 4) ? -1.f : 1.f;
    for (int item = blockIdx.x; item < T_ / 64; item += gridDim.x) {
        __syncthreads();
        for (int i0 = 0; i0 < 8; i0 += 4) {
          u32x2 cq_[4], q0_[4], q1_[4], q2_[4], k0_[4], k1_[4], k2_[4]; unsigned ckv_[4]; u32x4 vv_[4]; int pos_[4];
#pragma unroll
          for (int u = 0; u < 4; ++u) {
            const int t = item * 64 + wave * 8 + i0 + u; const bf16* pr = proj + (size_t)t * NPROJ;
            cq_[u] = *(const u32x2*)(pr + C_CQ + 4 * lane); ckv_[u] = *(const unsigned*)(pr + C_CKV + 2 * lane);
            q0_[u] = *(const u32x2*)(qraw + (size_t)t * 768 + hd * 96 + 4 * sub); q1_[u] = *(const u32x2*)(qraw + (size_t)t * 768 + hd * 96 + 4 * sub + 32); q2_[u] = *(const u32x2*)(qraw + (size_t)t * 768 + hd * 96 + 4 * sub + 64);
            k0_[u] = *(const u32x2*)(kvraw + (size_t)t * 1024 + hd * 128 + 4 * sub); k1_[u] = *(const u32x2*)(kvraw + (size_t)t * 1024 + hd * 128 + 4 * sub + 32); k2_[u] = *(const u32x2*)(pr + C_KPE + 4 * sub);
            vv_[u] = *(const u32x4*)(kvraw + (size_t)t * 1024 + hd * 128 + 64 + 8 * sub); pos_[u] = a.pos[t];
          }
#pragma unroll
          for (int u = 0; u < 4; ++u) {
            const int tl = wave * 8 + i0 + u, t = item * 64 + tl, b = t / S_, s = t % S_;
            const u32x2 cq = cq_[u], q0 = q0_[u], q1 = q1_[u], q2 = q2_[u], k0 = k0_[u], k1 = k1_[u], k2 = k2_[u]; const unsigned ckv = ckv_[u]; const u32x4 vv = vv_[u];
            float sq = bflo(cq.x) * bflo(cq.x) + bfhi(cq.x) * bfhi(cq.x) + bflo(cq.y) * bflo(cq.y) + bfhi(cq.y) * bfhi(cq.y);
            float sk = bflo(ckv) * bflo(ckv) + bfhi(ckv) * bfhi(ckv);
            const float rq = __builtin_amdgcn_rsqf(wave_sum_dpp(sq) * (1.f / 256.f) + EPS), rk = __builtin_amdgcn_rsqf(wave_sum_dpp(sk) * (1.f / 128.f) + EPS);
            const float p = (float)pos_[u];
            float sn[4], cs[4];
#pragma unroll
            for (int e = 0; e < 4; ++e) sincos_rev(p * ifr[e], sn[e], cs[e]);
            float v[12];
            v[0] = bflo(q0.x); v[1] = bfhi(q0.x); v[2] = bflo(q0.y); v[3] = bfhi(q0.y); v[4] = bflo(q1.x); v[5] = bfhi(q1.x); v[6] = bflo(q1.y); v[7] = bfhi(q1.y);
            v[8] = bflo(q2.x); v[9] = bfhi(q2.x); v[10] = bflo(q2.y); v[11] = bfhi(q2.y);
            float ss = 0.f;
#pragma unroll
            for (int j = 0; j < 12; ++j) { v[j] *= rq; ss += v[j] * v[j]; }
            ss = sum8_dpp(ss);
            float rn = __builtin_amdgcn_rsqf(ss * (1.f / 96.f) + EPS);
#pragma unroll
            for (int j = 0; j < 12; ++j) v[j] = v[j] * rn * gq[j];
#pragma unroll
            for (int e = 0; e < 4; ++e) { const float x = v[8 + e], pt = xor4_dpp(x, sub < 4); v[8 + e] = x * cs[e] + sgn * pt * sn[e]; }
            { bf16* qo = Q + ((size_t)(b * 8 + hd) * S_ + s) * 96 + 4 * sub;
#pragma unroll
              for (int jj = 0; jj < 3; ++jj) { u32x2 o; o.x = pk2(v[4 * jj], v[4 * jj + 1]); o.y = pk2(v[4 * jj + 2], v[4 * jj + 3]); *(u32x2*)(qo + 32 * jj) = o; } }
            v[0] = bflo(k0.x) * rk; v[1] = bfhi(k0.x) * rk; v[2] = bflo(k0.y) * rk; v[3] = bfhi(k0.y) * rk; v[4] = bflo(k1.x) * rk; v[5] = bfhi(k1.x) * rk; v[6] = bflo(k1.y) * rk; v[7] = bfhi(k1.y) * rk;
            v[8] = bflo(k2.x); v[9] = bfhi(k2.x); v[10] = bflo(k2.y); v[11] = bfhi(k2.y);
            ss = 0.f;
#pragma unroll
            for (int j = 0; j < 12; ++j) ss += v[j] * v[j];
            ss = sum8_dpp(ss);
            rn = __builtin_amdgcn_rsqf(ss * (1.f / 96.f) + EPS);
#pragma unroll
            for (int j = 0; j < 12; ++j) v[j] = v[j] * rn * gk[j];
#pragma unroll
            for (int e = 0; e < 4; ++e) { const float x = v[8 + e], pt = xor4_dpp(x, sub < 4); v[8 + e] = x * cs[e] + sgn * pt * sn[e]; }
            { bf16* ko = Kk + ((size_t)(b * 8 + hd) * S_ + s) * 96 + 4 * sub;
#pragma unroll
              for (int jj = 0; jj < 3; ++jj) { u32x2 o; o.x = pk2(v[4 * jj], v[4 * jj + 1]); o.y = pk2(v[4 * jj + 2], v[4 * jj + 3]); *(u32x2*)(ko + 32 * jj) = o; } }
            { LAS bf16* vt = vtile + (hd * 64 + 8 * sub) * 66 + tl;
              const unsigned p0 = pk2(bflo(vv.x) * rk, bfhi(vv.x) * rk), p1 = pk2(bflo(vv.y) * rk, bfhi(vv.y) * rk), p2 = pk2(bflo(vv.z) * rk, bfhi(vv.z) * rk), p3 = pk2(bflo(vv.w) * rk, bfhi(vv.w) * rk);
              vt[0 * 66] = (bf16)(p0 & 0xffffu); vt[1 * 66] = (bf16)(p0 >> 16); vt[2 * 66] = (bf16)(p1 & 0xffffu); vt[3 * 66] = (bf16)(p1 >> 16);
              vt[4 * 66] = (bf16)(p2 & 0xffffu); vt[5 * 66] = (bf16)(p2 >> 16); vt[6 * 66] = (bf16)(p3 & 0xffffu); vt[7 * 66] = (bf16)(p3 >> 16); }
          }
        }
        __syncthreads();
        { const int b = (item * 64) / S_, s0 = (item * 64) % S_; const int c8 = tid & 7;
#pragma unroll
          for (int k = 0; k < 8; ++k) { const int row = (tid >> 3) + 64 * k;
              const LAS unsigned* src = (const LAS unsigned*)(vtile + row * 66 + c8 * 8);
              u32x4 o; o.x = src[0]; o.y = src[1]; o.z = src[2]; o.w = src[3];
              *(u32x4*)(Vt + ((size_t)b * 512 + row) * S_ + s0 + 8 * c8) = o; } }
    }
    __syncthreads();
}
__device__ __forceinline__ short __attribute__((ext_vector_type(8))) scale8(const short __attribute__((ext_vector_type(8))) x, const f32x4 w0, const f32x4 w1) {
    const u32x4 v = __builtin_bit_cast(u32x4, x); u32x4 o;
    o.x = pk2(bflo(v.x) * w0.x, bfhi(v.x) * w0.y); o.y = pk2(bflo(v.y) * w0.z, bfhi(v.y) * w0.w); o.z = pk2(bflo(v.z) * w1.x, bfhi(v.z) * w1.y); o.w = pk2(bflo(v.w) * w1.z, bfhi(v.w) * w1.w);
    return __builtin_bit_cast(short __attribute__((ext_vector_type(8))), o);
}
__device__ __forceinline__ void ssd_chunk_states(const Args& a, LAS unsigned char* lds) {
    const int tid = opaque_tid(), lane = tid & 63, w = tid >> 6, r = lane & 31, hh = lane >> 5;
    const int nblk = w & 3, pblk = w >> 2;
    const bf16* Bt = (const bf16*)(a.ws + WS_BT); const bf16* Xt = (const bf16*)(a.ws + WS_XT);
    const float* vec = (const float*)(a.ws + WS_VEC);
    const size_t VS = (size_t)NB * 8 * S_;
    bf16* Sst = (bf16*)a.out;
    constexpr int ROWB = 528, XOFF = 128 * ROWB, WOFF = XOFF + 64 * ROWB;
    LAS float* wl = (LAS float*)(lds + WOFF);
    const int crow = tid >> 5, cc = tid & 31;
    for (int item = blockIdx.x; item < NB * 8 * 8; item += gridDim.x) {
        const int qb = item & 7, head = (item >> 3) & 7, b = item >> 6, g = head >> 2;
        const int L0 = qb * 256;
        const bf16* Ab = Bt + (size_t)(b * 2 + g) * 128 * S_ + L0;
        const bf16* Xb = Xt + (size_t)(b * 8 + head) * 64 * S_ + L0;
        u32x4 st[12];
#pragma unroll
        for (int i = 0; i < 8; ++i) st[i] = *(const u32x4*)(Ab + (size_t)(16 * i + crow) * S_ + 8 * cc);
#pragma unroll
        for (int i = 0; i < 4; ++i) st[8 + i] = *(const u32x4*)(Xb + (size_t)(16 * i + crow) * S_ + 8 * cc);
        const float wv = vec[(6 + (tid >> 8)) * VS + ((size_t)b * 8 + head) * S_ + L0 + (tid & 255)];
        __syncthreads();
#pragma unroll
        for (int i = 0; i < 8; ++i) *(LAS u32x4*)(lds + (16 * i + crow) * ROWB + 16 * cc) = st[i];
#pragma unroll
        for (int i = 0; i < 4; ++i) *(LAS u32x4*)(lds + XOFF + (16 * i + crow) * ROWB + 16 * cc) = st[8 + i];
        wl[tid] = wv;
        __syncthreads();
        f32x16 accf, accb;
#pragma unroll
        for (int i = 0; i < 16; ++i) { accf[i] = 0.f; accb[i] = 0.f; }
        const LAS unsigned char* ap = lds + (32 * nblk + r) * ROWB + 16 * hh;
        const LAS unsigned char* xp = lds + XOFF + (32 * pblk + r) * ROWB + 16 * hh;
#pragma unroll
        for (int u = 0; u < 16; ++u) {
            const bf16x8 A = *(const LAS bf16x8*)(ap + 32 * u), X = *(const LAS bf16x8*)(xp + 32 * u);
            const f32x4 F0 = *(const LAS f32x4*)(wl + 16 * u + 8 * hh), F1 = *(const LAS f32x4*)(wl + 16 * u + 8 * hh + 4);
            const f32x4 G0 = *(const LAS f32x4*)(wl + 256 + 16 * u + 8 * hh), G1 = *(const LAS f32x4*)(wl + 256 + 16 * u + 8 * hh + 4);
            accf = MFMA32(A, scale8(X, F0, F1), accf); accb = MFMA32(A, scale8(X, G0, G1), accb);
        }
        bf16* of = Sst + ((((size_t)(b * 8 + head) * 2 + 0) * 8 + qb) * 64 + 32 * pblk + r) * 128 + 32 * nblk + 4 * hh;
        bf16* ob = of + (size_t)8 * 64 * 128;
#pragma unroll
        for (int g4 = 0; g4 < 4; ++g4) {
            u32x2 v; v.x = pk2(accf[4 * g4], accf[4 * g4 + 1]); v.y = pk2(accf[4 * g4 + 2], accf[4 * g4 + 3]); *(u32x2*)(of + 8 * g4) = v;
            u32x2 q; q.x = pk2(accb[4 * g4], accb[4 * g4 + 1]); q.y = pk2(accb[4 * g4 + 2], accb[4 * g4 + 3]); *(u32x2*)(ob + 8 * g4) = q; }
    }
    __syncthreads();
}
__device__ __forceinline__ void ssd_state_scan(const Args& a) {
    const int tid = opaque_tid();
    const float* vec = (const float*)(a.ws + WS_VEC);
    const size_t VS = (size_t)NB * 8 * S_;
    const bf16* Sst = (const bf16*)a.out; bf16* Hst = (bf16*)a.out + HST_OFF;
    for (int e = blockIdx.x * NTHREADS + tid; e < NB * 8 * 2 * 1024; e += gridDim.x * NTHREADS) {
        const int seq = e >> 10, off = (e & 1023) * 8, dir = seq & 1, bh = seq >> 1;
        const float* vb = vec + (size_t)bh * S_;
        const size_t base = (size_t)seq * 8 * 8192 + off;
        u32x4 sv[8]; float dec[8];
#pragma unroll
        for (int i = 0; i < 8; ++i) { const int qb = dir ? 7 - i : i; sv[i] = *(const u32x4*)(Sst + base + (size_t)qb * 8192);
            const int L0 = qb * 256, L1 = L0 + 255;
            if (dir == 0) dec[i] = ex2(vb[L1] - (qb ? vb[L0 - 1] : 0.f)); else dec[i] = ex2(vb[VS + L0] - (qb < 7 ? vb[VS + L1 + 1] : 0.f)); }
        float h[8];
#pragma unroll
        for (int k = 0; k < 8; ++k) h[k] = 0.f;
#pragma unroll
        for (int i = 0; i < 8; ++i) { const int qb = dir ? 7 - i : i;
            u32x4 o; o.x = pk2(h[0], h[1]); o.y = pk2(h[2], h[3]); o.z = pk2(h[4], h[5]); o.w = pk2(h[6], h[7]);
            *(u32x4*)(Hst + base + (size_t)qb * 8192) = o;
            const u32x4 v = sv[i]; const float d = dec[i];
            h[0] = h[0] * d + bflo(v.x); h[1] = h[1] * d + bfhi(v.x); h[2] = h[2] * d + bflo(v.y); h[3] = h[3] * d + bfhi(v.y);
            h[4] = h[4] * d + bflo(v.z); h[5] = h[5] * d + bfhi(v.z); h[6] = h[6] * d + bflo(v.w); h[7] = h[7] * d + bfhi(v.w); }
    }
}

__device__ __forceinline__ bf16x8 pack8(float a0, float a1, float a2, float a3, float a4, float a5, float a6, float a7) {
    u32x4 p; p.x = pk2(a0, a1); p.y = pk2(a2, a3); p.z = pk2(a4, a5); p.w = pk2(a6, a7); return __builtin_bit_cast(bf16x8, p);
}
__device__ __forceinline__ bf16x8 ld_vfrag(const LAS unsigned char* p) {
    return *(const LAS bf16x8*)p;
}
constexpr int AT_KROW = 208, AT_VROW = 144, AT_KBYTES = 64 * AT_KROW, AT_BUF = AT_KBYTES + 64 * AT_VROW;
__device__ __forceinline__ void attn_item(LAS unsigned char* lds, const bf16* Q, const bf16* Kg, const bf16* Vt, bf16* O, float* ssqa, int b, int h, int qb, float mb) {
    const int tid = opaque_tid(), lane = tid & 63, w = tid >> 6, r = lane & 31, hh = lane >> 5;
    const size_t bh = (size_t)(b * 8 + h);
    const int qrow = qb * 256 + w * 32 + r;
    bf16x8 qf[6];
    { const bf16* Qp = Q + (bh * S_ + qrow) * 96 + 8 * hh;
#pragma unroll
      for (int s = 0; s < 6; ++s) qf[s] = *(const bf16x8*)(Qp + 16 * s); }
    const unsigned char* Kp = (const unsigned char*)(Kg + bh * S_ * 96);
    const bf16* Vp = Vt + bh * 64 * S_;
    const int vrow = tid >> 3, vc8 = tid & 7;
    const int kc0 = tid, kc1 = tid + 512;
    const unsigned koff0 = (kc0 / 12) * AT_KROW + (kc0 % 12) * 16, koff1 = (kc1 / 12) * AT_KROW + (kc1 % 12) * 16;
    const unsigned voff = AT_KBYTES + vrow * AT_VROW + (vc8 >> 1) * 32 + (vc8 & 1) * 8;
    u32x4 kr0, kr1 = {0, 0, 0, 0}, vr;
#define AT_LOAD(j) do { kr0 = *(const u32x4*)(Kp + (size_t)(j) * 12288 + kc0 * 16); if (tid < 256) kr1 = *(const u32x4*)(Kp + (size_t)(j) * 12288 + kc1 * 16); \
        vr = *(const u32x4*)(Vp + (size_t)vrow * S_ + (j) * 64 + vc8 * 8); } while (0)
#define AT_STORE(buf) do { LAS unsigned char* bb = lds + (buf) * AT_BUF; *(LAS u32x4*)(bb + koff0) = kr0; if (tid < 256) *(LAS u32x4*)(bb + koff1) = kr1; \
        *(LAS u32x2*)(bb + voff) = (u32x2){vr.x, vr.y}; *(LAS u32x2*)(bb + voff + 16) = (u32x2){vr.z, vr.w}; } while (0)
    __syncthreads();
    AT_LOAD(0); AT_STORE(0);
    __syncthreads();
    f32x16 o0, o1, nmbv;
#pragma unroll
    for (int i = 0; i < 16; ++i) { o0[i] = 0.f; o1[i] = 0.f; nmbv[i] = -mb; }
    f32x2 ls2 = {0.f, 0.f};
    for (int j = 0; j < 32; ++j) {
        if (j + 1 < 32) AT_LOAD(j + 1);
        const LAS unsigned char* kb_ = lds + (j & 1) * AT_BUF;
        const LAS unsigned char* vb_ = kb_ + AT_KBYTES;
        bf16x8 kf[6];
#pragma unroll
        for (int s = 0; s < 6; ++s) kf[s] = *(const LAS bf16x8*)(kb_ + r * AT_KROW + 32 * s + 16 * hh);
#pragma unroll
        for (int kb = 0; kb < 2; ++kb) {
            f32x16 sT = MFMA32(kf[0], qf[0], nmbv);
#pragma unroll
            for (int s = 1; s < 6; ++s) sT = MFMA32(kf[s], qf[s], sT);
            bf16x8 vf[2][2];
#pragma unroll
            for (int ks = 0; ks < 2; ++ks) { vf[ks][0] = ld_vfrag(vb_ + r * AT_VROW + (2 * kb + ks) * 32 + 16 * hh); vf[ks][1] = ld_vfrag(vb_ + (32 + r) * AT_VROW + (2 * kb + ks) * 32 + 16 * hh); }
            if (kb == 0) {
#pragma unroll
                for (int s = 0; s < 6; ++s) kf[s] = *(const LAS bf16x8*)(kb_ + (32 + r) * AT_KROW + 32 * s + 16 * hh);
            }
            __builtin_amdgcn_sched_barrier(0);
#pragma unroll
            for (int i = 0; i < 16; i += 2) { sT[i] = ex2(sT[i]); sT[i + 1] = ex2(sT[i + 1]); ls2 += (f32x2){sT[i], sT[i + 1]}; }
            __builtin_amdgcn_sched_barrier(0);
#pragma unroll
            for (int ks = 0; ks < 2; ++ks) {
                const bf16x8 pf = pack8(sT[8 * ks], sT[8 * ks + 1], sT[8 * ks + 2], sT[8 * ks + 3], sT[8 * ks + 4], sT[8 * ks + 5], sT[8 * ks + 6], sT[8 * ks + 7]);
                o0 = MFMA32(vf[ks][0], pf, o0); o1 = MFMA32(vf[ks][1], pf, o1);
            }
        }
        if (j + 1 < 32) AT_STORE((j + 1) & 1);
        __syncthreads();
    }
    float lsum = ls2.x + ls2.y;
#undef AT_LOAD
#undef AT_STORE
    lsum += __shfl_xor(lsum, 32);
    const float inv = 1.f / lsum;
    LAS unsigned char* img = lds + w * (32 * 272);
    { float sq = 0.f;
#pragma unroll
      for (int i = 0; i < 16; ++i) { const float p0 = o0[i] * inv, p1 = o1[i] * inv; sq += p0 * p0 + p1 * p1; }
      sq += __shfl_xor(sq, 32);
      if (hh == 0) atomicAdd(ssqa + (size_t)b * S_ + qrow, sq); }
#pragma unroll
    for (int g4 = 0; g4 < 4; ++g4) {
        *(LAS f32x4*)(img + r * 272 + (8 * g4 + 4 * hh) * 4) = (f32x4){o0[4 * g4] * inv, o0[4 * g4 + 1] * inv, o0[4 * g4 + 2] * inv, o0[4 * g4 + 3] * inv};
        *(LAS f32x4*)(img + r * 272 + (32 + 8 * g4 + 4 * hh) * 4) = (f32x4){o1[4 * g4] * inv, o1[4 * g4 + 1] * inv, o1[4 * g4 + 2] * inv, o1[4 * g4 + 3] * inv};
    }
    const int er = lane >> 3, ec = lane & 7;
#pragma unroll
    for (int k = 0; k < 4; ++k) {
        const f32x4 v0 = *(const LAS f32x4*)(img + (er + 8 * k) * 272 + ec * 32), v1 = *(const LAS f32x4*)(img + (er + 8 * k) * 272 + ec * 32 + 16);
        u32x4 o; o.x = pk2(v0[0], v0[1]); o.y = pk2(v0[2], v0[3]); o.z = pk2(v1[0], v1[1]); o.w = pk2(v1[2], v1[3]);
        *(u32x4*)(O + ((size_t)b * S_ + qb * 256 + w * 32 + er + 8 * k) * 1024 + h * 64 + 8 * ec) = o;
    }
}

constexpr int SD_BROW = 272, SD_XROW = 144, SD_BBYTES = 64 * SD_BROW, SD_XBYTES = 64 * SD_XROW, SD_VEC = SD_BBYTES + 2 * SD_XBYTES, SD_BUF = SD_VEC + 2 * 6 * 256;
__device__ __forceinline__ void ssd_item(LAS unsigned char* lds, const Args& a, int b, int hp, int qb) {
    const int tid = opaque_tid(), lane = tid & 63, w = tid >> 6, r = lane & 31, hh = lane >> 5;
    const int g = hp >> 1, h0 = hp * 2;
    const bf16* Bm = (const bf16*)(a.ws + WS_BM); const bf16* Cm = (const bf16*)(a.ws + WS_CM); const bf16* Xt = (const bf16*)(a.ws + WS_XT);
    const float* vec = (const float*)(a.ws + WS_VEC);
    const size_t VS = (size_t)NB * 8 * S_;
    const int l0 = qb * 256 + w * 32, l = l0 + r;
    bf16x8 cf[8];
    { const bf16* Cp = Cm + ((size_t)(b * 2 + g) * S_ + l) * 128 + 8 * hh;
#pragma unroll
      for (int s = 0; s < 8; ++s) cf[s] = *(const bf16x8*)(Cp + 16 * s); }
    float afl[2], rbl[2], dsk[2];
#pragma unroll
    for (int hd = 0; hd < 2; ++hd) { const float* vb = vec + ((size_t)b * 8 + h0 + hd) * S_; afl[hd] = vb[l]; rbl[hd] = vb[VS + l]; dsk[hd] = a.d_skip[h0 + hd]; }
    const unsigned char* Bp = (const unsigned char*)(Bm + (size_t)(b * 2 + g) * S_ * 128);
    const int xrow = tid >> 3, xc8 = tid & 7;
    const bf16* Xp0 = Xt + ((size_t)(b * 8 + h0) * 64 + xrow) * S_ + xc8 * 8;
    const bf16* Xp1 = Xp0 + (size_t)64 * S_;
    const int bc0 = tid, bc1 = tid + 512;
    const unsigned boff0 = (bc0 >> 4) * SD_BROW + (bc0 & 15) * 16, boff1 = (bc1 >> 4) * SD_BROW + (bc1 & 15) * 16;
    const unsigned xoff = SD_BBYTES + xrow * SD_XROW + (xc8 >> 1) * 32 + (xc8 & 1) * 8;
    const int vhd = tid / 96, vrem = tid % 96, varr = vrem >> 4, vc = vrem & 15;
    const float* vsrc = vec + (size_t)varr * VS + ((size_t)b * 8 + h0 + vhd) * S_ + 4 * vc;
    const unsigned voff = SD_VEC + ((vhd * 6 + varr) * 64 + 4 * vc) * 4;
    u32x4 br0, br1, xr0, xr1; f32x4 vr = {0.f, 0.f, 0.f, 0.f};
#define SD_LOAD(j) do { br0 = *(const u32x4*)(Bp + (size_t)(j) * 16384 + bc0 * 16); br1 = *(const u32x4*)(Bp + (size_t)(j) * 16384 + bc1 * 16); \
        xr0 = *(const u32x4*)(Xp0 + (j) * 64); xr1 = *(const u32x4*)(Xp1 + (j) * 64); if (tid < 192) vr = *(const f32x4*)(vsrc + (j) * 64); } while (0)
#define SD_STORE(buf) do { LAS unsigned char* bb = lds + (buf) * SD_BUF; *(LAS u32x4*)(bb + boff0) = br0; *(LAS u32x4*)(bb + boff1) = br1; \
        *(LAS u32x2*)(bb + xoff) = (u32x2){xr0.x, xr0.y}; *(LAS u32x2*)(bb + xoff + 16) = (u32x2){xr0.z, xr0.w}; \
        *(LAS u32x2*)(bb + xoff + SD_XBYTES) = (u32x2){xr1.x, xr1.y}; *(LAS u32x2*)(bb + xoff + SD_XBYTES + 16) = (u32x2){xr1.z, xr1.w}; \
        if (tid < 192) *(LAS f32x4*)(bb + voff) = vr; } while (0)
    const int j0 = qb * 4, j1 = j0 + 4;
    __syncthreads();
    SD_LOAD(j0); SD_STORE(j0 & 1);
    __syncthreads();
    f32x16 y[2][2], zero16;
#pragma unroll
    for (int i = 0; i < 16; ++i) zero16[i] = 0.f;
#pragma unroll
    for (int i = 0; i < 16; ++i) { y[0][0][i] = 0.f; y[0][1][i] = 0.f; y[1][0][i] = 0.f; y[1][1][i] = 0.f; }
    for (int j = j0; j < j1; ++j) {
        if (j + 1 < j1) SD_LOAD(j + 1);
        const LAS unsigned char* bb = lds + (j & 1) * SD_BUF;
        const int key0 = j * 64;
        const int type = (key0 + 63 < l0) ? 0 : ((key0 > l0 + 31) ? 1 : 2);
#pragma unroll
        for (int kb = 0; kb < 2; ++kb) {
            f32x16 sT;
#pragma unroll
            for (int i = 0; i < 16; ++i) sT[i] = 0.f;
#pragma unroll
            for (int s = 0; s < 8; ++s) { const bf16x8 bf_ = *(const LAS bf16x8*)(bb + (32 * kb + r) * SD_BROW + 32 * s + 16 * hh); sT = MFMA32(bf_, cf[s], sT); }
#pragma unroll
            for (int hd = 0; hd < 2; ++hd) {
                const LAS float* vv = (const LAS float*)(bb + SD_VEC + hd * 6 * 256);
                const LAS unsigned char* xb = bb + SD_BBYTES + hd * SD_XBYTES;
                float p[16];
                if (type != 2) {
                    const float coef = (type == 0) ? ex2(afl[hd] - vv[63]) : ex2(rbl[hd] - vv[64]);
                    const LAS float* vt = vv + (type == 0 ? 128 : 192) + 32 * kb + 4 * hh;
#pragma unroll
                    for (int g4 = 0; g4 < 4; ++g4) { const f32x4 t4 = *(const LAS f32x4*)(vt + 8 * g4);
#pragma unroll
                        for (int e = 0; e < 4; ++e) p[4 * g4 + e] = sT[4 * g4 + e] * (t4[e] * coef); }
                } else {
#pragma unroll
                    for (int g4 = 0; g4 < 4; ++g4) {
                        const int kk = 32 * kb + 8 * g4 + 4 * hh;
                        const f32x4 af4 = *(const LAS f32x4*)(vv + kk), rb4 = *(const LAS f32x4*)(vv + 64 + kk), df4 = *(const LAS f32x4*)(vv + 256 + kk), db4 = *(const LAS f32x4*)(vv + 320 + kk);
#pragma unroll
                        for (int e = 0; e < 4; ++e) {
                            const int s = key0 + kk + e;
                            const bool fwd = (s <= l);
                            const float arg = fwd ? (afl[hd] - af4[e]) : (rbl[hd] - rb4[e]);
                            float wgt = ex2(fminf(arg, 0.f)) * (fwd ? df4[e] : db4[e]);
                            if (s == l) wgt += db4[e];
                            float pv = sT[4 * g4 + e] * wgt;
                            if (s == l) pv += dsk[hd];
                            p[4 * g4 + e] = pv;
                        }
                        __builtin_amdgcn_sched_barrier(0);
                    }
                }
#pragma unroll
                for (int ks = 0; ks < 2; ++ks) {
                    const bf16x8 pf = pack8(p[8 * ks], p[8 * ks + 1], p[8 * ks + 2], p[8 * ks + 3], p[8 * ks + 4], p[8 * ks + 5], p[8 * ks + 6], p[8 * ks + 7]);
                    const bf16x8 x0 = ld_vfrag(xb + r * SD_XROW + (2 * kb + ks) * 32 + 16 * hh);
                    const bf16x8 x1 = ld_vfrag(xb + (32 + r) * SD_XROW + (2 * kb + ks) * 32 + 16 * hh);
                    y[hd][0] = MFMA32(x0, pf, y[hd][0]); y[hd][1] = MFMA32(x1, pf, y[hd][1]);
                }
            }
        }
        if (j + 1 < j1) SD_STORE((j + 1) & 1);
        __syncthreads();
    }
    {
        const bf16* Hst = (const bf16*)a.out + HST_OFF;
        const int Lb = qb * 256;
        u32x4 hreg[8];
#pragma unroll
        for (int tq = 0; tq < 4; ++tq)
#pragma unroll
            for (int i = 0; i < 2; ++i) { const int id = tid + 512 * i;
                hreg[2 * tq + i] = *(const u32x4*)(Hst + ((((size_t)(b * 8 + h0 + (tq >> 1)) * 2 + (tq & 1)) * 8 + qb) * 64) * 128 + (size_t)id * 8); }
#pragma unroll
        for (int tq = 0; tq < 4; ++tq)
#pragma unroll
            for (int i = 0; i < 2; ++i) { const int id = tid + 512 * i; *(LAS u32x4*)(lds + tq * (64 * 272) + (id >> 4) * 272 + (id & 15) * 16) = hreg[2 * tq + i]; }
        __syncthreads();
#pragma unroll
        for (int hd = 0; hd < 2; ++hd) {
            const float* vb = vec + ((size_t)b * 8 + h0 + hd) * S_;
            const float uf = ex2(afl[hd] - (qb ? vb[Lb - 1] : 0.f)), ub = ex2(rbl[hd] - (qb < 7 ? vb[VS + Lb + 256] : 0.f));
#pragma unroll
            for (int dir = 0; dir < 2; ++dir) {
                const LAS unsigned char* hp = lds + (hd * 2 + dir) * (64 * 272) + r * 272 + 16 * hh;
                const float uu = dir ? ub : uf;
#pragma unroll
                for (int db = 0; db < 2; ++db) {
                    f32x16 z = zero16;
#pragma unroll
                    for (int s = 0; s < 8; ++s) { const bf16x8 hf = *(const LAS bf16x8*)(hp + db * 32 * 272 + 32 * s); z = MFMA32(hf, cf[s], z); }
#pragma unroll
                    for (int i = 0; i < 16; ++i) y[hd][db][i] += uu * z[i];
                }
            }
        }
    }
#undef SD_LOAD
#undef SD_STORE
    const bf16* proj = (const bf16*)(a.ws + WS_PROJ); bf16* YG = (bf16*)(a.ws + WS_MIXRAW) + 512; float* ssqy = (float*)(a.ws + WS_SSQY);
    __syncthreads();
    LAS unsigned char* img = lds + w * (32 * 528);
#pragma unroll
    for (int hd = 0; hd < 2; ++hd)
#pragma unroll
        for (int db = 0; db < 2; ++db)
#pragma unroll
            for (int g4 = 0; g4 < 4; ++g4)
                *(LAS f32x4*)(img + r * 528 + (hd * 64 + 32 * db + 8 * g4 + 4 * hh) * 4) = (f32x4){y[hd][db][4 * g4], y[hd][db][4 * g4 + 1], y[hd][db][4 * g4 + 2], y[hd][db][4 * g4 + 3]};
    const int er = lane >> 4, ec = lane & 15;
    u32x4 zz[8];
#pragma unroll
    for (int k = 0; k < 8; ++k) zz[k] = *(const u32x4*)(proj + ((size_t)b * S_ + l0 + er + 4 * k) * NPROJ + C_Z + h0 * 64 + 8 * ec);
#pragma unroll
    for (int k = 0; k < 8; ++k) {
        const f32x4 v0 = *(const LAS f32x4*)(img + (er + 4 * k) * 528 + ec * 32), v1 = *(const LAS f32x4*)(img + (er + 4 * k) * 528 + ec * 32 + 16);
        const u32x4 z = zz[k]; u32x4 o;
        const float g0 = v0[0] * silu(bflo(z.x)), g1 = v0[1] * silu(bfhi(z.x)), g2 = v0[2] * silu(bflo(z.y)), g3 = v0[3] * silu(bfhi(z.y));
        const float g4_ = v1[0] * silu(bflo(z.z)), g5 = v1[1] * silu(bfhi(z.z)), g6 = v1[2] * silu(bflo(z.w)), g7 = v1[3] * silu(bfhi(z.w));
        o.x = pk2(g0, g1); o.y = pk2(g2, g3); o.z = pk2(g4_, g5); o.w = pk2(g6, g7);
        *(u32x4*)(YG + ((size_t)b * S_ + l0 + er + 4 * k) * 1024 + h0 * 64 + 8 * ec) = o;
        float sq = (g0 * g0 + g1 * g1) + (g2 * g2 + g3 * g3) + (g4_ * g4_ + g5 * g5) + (g6 * g6 + g7 * g7);
        sq += __shfl_xor(sq, 1); sq += __shfl_xor(sq, 2); sq += __shfl_xor(sq, 4); sq += __shfl_xor(sq, 8);
        if (ec == 0) atomicAdd(ssqy + 2 * ((size_t)b * S_ + l0 + er + 4 * k) + g, sq);
    }
}

__device__ __forceinline__ void p5_mix(const Args& a) {
    const int tid = opaque_tid(), lane = tid & 63, wave = tid >> 6;
    const int gw = blockIdx.x * NWAVES + wave, NGW = gridDim.x * NWAVES;
    const bf16* AO = (const bf16*)(a.ws + WS_ATTNO); const bf16* YG = (const bf16*)(a.ws + WS_YG); bf16* MIX = (bf16*)(a.ws + WS_HB);
    float ga[8], gs[8];
#pragma unroll
    for (int e = 0; e < 8; ++e) { ga[e] = a.attn_out_g[8 * lane + e]; gs[e] = a.ssm_norm_g[8 * lane + e]; }
    for (int t0 = gw; t0 < T_; t0 += 4 * NGW) {
        u32x4 avv[4], yvv[4];
#pragma unroll
        for (int u = 0; u < 4; ++u) { const int t = t0 + u * NGW; if (t < T_) { avv[u] = *(const u32x4*)(AO + (size_t)t * 512 + 8 * lane); yvv[u] = *(const u32x4*)(YG + (size_t)t * 512 + 8 * lane); } else { avv[u] = (u32x4){0u, 0u, 0u, 0u}; yvv[u] = avv[u]; } }
#pragma unroll
        for (int u = 0; u < 4; ++u) {
        const int t = t0 + u * NGW; if (t >= T_) break;
        const u32x4 av = avv[u], yv = yvv[u];
        float x[8], yy[8];
        x[0] = bflo(av.x); x[1] = bfhi(av.x); x[2] = bflo(av.y); x[3] = bfhi(av.y); x[4] = bflo(av.z); x[5] = bfhi(av.z); x[6] = bflo(av.w); x[7] = bfhi(av.w);
        yy[0] = bflo(yv.x); yy[1] = bfhi(yv.x); yy[2] = bflo(yv.y); yy[3] = bfhi(yv.y); yy[4] = bflo(yv.z); yy[5] = bfhi(yv.z); yy[6] = bflo(yv.w); yy[7] = bfhi(yv.w);
        float sa = 0.f, sy = 0.f;
#pragma unroll
        for (int e = 0; e < 8; ++e) { sa += x[e] * x[e]; sy += yy[e] * yy[e]; }
        sa = wave_sum(sa);
#pragma unroll
        for (int o = 1; o < 32; o <<= 1) sy += __shfl_xor(sy, o);
        const float ra = 1.f / sqrtf(sa * (1.f / 512.f) + EPS), ry = 1.f / sqrtf(sy * (1.f / 256.f) + EPS);
        u32x4 oa, oy;
        oa.x = pk2(x[0] * ra * ga[0], x[1] * ra * ga[1]); oa.y = pk2(x[2] * ra * ga[2], x[3] * ra * ga[3]); oa.z = pk2(x[4] * ra * ga[4], x[5] * ra * ga[5]); oa.w = pk2(x[6] * ra * ga[6], x[7] * ra * ga[7]);
        oy.x = pk2(yy[0] * ry * gs[0], yy[1] * ry * gs[1]); oy.y = pk2(yy[2] * ry * gs[2], yy[3] * ry * gs[3]); oy.z = pk2(yy[4] * ry * gs[4], yy[5] * ry * gs[5]); oy.w = pk2(yy[6] * ry * gs[6], yy[7] * ry * gs[7]);
        *(u32x4*)(MIX + (size_t)t * D_ + 8 * lane) = oa; *(u32x4*)(MIX + (size_t)t * D_ + 512 + 8 * lane) = oy;
    }
        }
}

#define XB_TMO      128
#define XB_XCNT(j)  (256  + 64 * (j))
#define XB_XSUB(j)  (1280 + 64 * (j))
#define XB_XGEN(j)  (2304 + 64 * (j))
#define XB_TOP      3328
#define XB_TOPGEN   3392
#define XCD_BAR_WORDS 3456
#define XB_SPIN_CAP (1u << 18)

__device__ __forceinline__ unsigned xb_ld(unsigned* p)              { return __hip_atomic_load(p, __ATOMIC_RELAXED, __HIP_MEMORY_SCOPE_AGENT); }
__device__ __forceinline__ unsigned xb_add(unsigned* p, unsigned v) { return __hip_atomic_fetch_add(p, v, __ATOMIC_RELAXED, __HIP_MEMORY_SCOPE_AGENT); }
__device__ __forceinline__ unsigned xb_xcc_id() { return (unsigned)__builtin_amdgcn_s_getreg((3 << 11) | 20) & 0xFu; }
#define XB_SPIN(cond, bar) do { unsigned _sp = 0; while (cond) { __builtin_amdgcn_s_sleep(1); \
    if ((++_sp & 255u) == 0u) { if (xb_ld(&(bar)[XB_TMO])) break; if (_sp > XB_SPIN_CAP) { atomicAdd(&(bar)[XB_TMO], 1u); break; } } } } while (0)

struct XcdBarrier {
    unsigned* bar; unsigned x;
    volatile LAS unsigned* st;
};

__device__ __forceinline__ XcdBarrier xcd_barrier_post(unsigned* bar, volatile LAS unsigned* st) {
    XcdBarrier b; b.bar = bar; b.x = xb_xcc_id(); b.st = st;
    if (threadIdx.x == 0) (void)xb_add(&bar[XB_XCNT(b.x)], 1u);
    return b;
}
__device__ __forceinline__ void xcd_barrier_complete(unsigned* bar, unsigned x, unsigned& nloc, unsigned& nx) {
    const unsigned G = gridDim.x * gridDim.y * gridDim.z;
    unsigned sum, cnt, mine, sp = 0u;
    for (;;) {
        sum = 0u; cnt = 0u; mine = 0u;
#pragma unroll
        for (unsigned j = 0; j < 16; ++j) { const unsigned c = xb_ld(&bar[XB_XCNT(j)]); sum += c; cnt += (c > 0u) ? 1u : 0u; mine = (j == x) ? c : mine; }
        if (sum == G) break;
        __builtin_amdgcn_s_sleep(1);
        if ((++sp & 255u) == 0u) { if (xb_ld(&bar[XB_TMO])) break; if (sp > XB_SPIN_CAP) { atomicAdd(&bar[XB_TMO], 1u); break; } }
    }
    nloc = mine > 0u ? mine : 1u; nx = cnt > 0u ? cnt : 1u;
}

__device__ __forceinline__ void xcd_barrier(const XcdBarrier& b) {
    asm volatile("s_waitcnt vmcnt(0)" ::: "memory");
    __syncthreads();
    if (threadIdx.x == 0) {
        unsigned* bar = b.bar;
        __builtin_amdgcn_s_waitcnt(0);
        unsigned nloc = b.st[0], nx = b.st[1];
        if (nloc == 0u) { xcd_barrier_complete(bar, b.x, nloc, nx); b.st[0] = nloc; b.st[1] = nx; }
        const unsigned old = xb_add(&bar[XB_XSUB(b.x)], 1u);
        const unsigned gen = old / nloc;
        if (old + 1u == (gen + 1u) * nloc) {
            __builtin_amdgcn_fence(__ATOMIC_RELEASE, "agent");
            asm volatile("s_waitcnt vmcnt(0)" ::: "memory");
            const unsigned og = xb_add(&bar[XB_TOP], 1u);
            const unsigned tg = og / nx;
            if (og + 1u == (tg + 1u) * nx) xb_add(&bar[XB_TOPGEN], 1u);
            else XB_SPIN(xb_ld(&bar[XB_TOPGEN]) == tg, bar);
            __builtin_amdgcn_fence(__ATOMIC_ACQUIRE, "agent");
            xb_add(&bar[XB_XGEN(b.x)], 1u);
            asm volatile("s_waitcnt vmcnt(0)" ::: "memory");
        } else {
            XB_SPIN(xb_ld(&bar[XB_XGEN(b.x)]) == gen, bar);
            __builtin_amdgcn_fence(__ATOMIC_ACQUIRE, "agent");
            asm volatile("s_waitcnt vmcnt(0)" ::: "memory");
        }
    }
    __syncthreads();
}

__device__ __forceinline__ void split_arrive(unsigned* cnt) {
    asm volatile("s_waitcnt vmcnt(0)" ::: "memory");
    __syncthreads();
    if (threadIdx.x == 0) { __builtin_amdgcn_fence(__ATOMIC_RELEASE, "agent"); asm volatile("s_waitcnt vmcnt(0)" ::: "memory"); (void)__hip_atomic_fetch_add(cnt, 1u, __ATOMIC_RELAXED, __HIP_MEMORY_SCOPE_AGENT); }
}
__device__ __forceinline__ void split_wait(unsigned* cnt, unsigned want) {
    if (threadIdx.x == 0) { unsigned sp = 0; while (__hip_atomic_load(cnt, __ATOMIC_RELAXED, __HIP_MEMORY_SCOPE_AGENT) < want) { __builtin_amdgcn_s_sleep(1); if (++sp > (1u << 22)) break; }
        __builtin_amdgcn_fence(__ATOMIC_ACQUIRE, "agent"); asm volatile("s_waitcnt vmcnt(0)" ::: "memory"); }
    __syncthreads();
}

#define REP_P0 1
#define REP_P23 1
#define REP_P5 1
#ifndef REP_P4
#define REP_P4 1
#endif
__global__ void __launch_bounds__(NTHREADS, 2) fwd_megakernel(Args a) {
    extern __shared__ __attribute__((aligned(16))) unsigned char lds_raw[];
    LAS unsigned char* lds = (LAS unsigned char*)lds_raw;
    cg::grid_group grid = cg::this_grid();
    unsigned char* ws = a.ws;
    const int G = gridDim.x, bx = blockIdx.x;
    const int tid = opaque_tid(), lane = tid & 63, wave = tid >> 6;
    volatile LAS unsigned* MISC = (volatile LAS unsigned*)(lds + MISC_OFF);
    if (threadIdx.x < 16) MISC[threadIdx.x] = 0u;
    __syncthreads();
    XcdBarrier bar = xcd_barrier_post((unsigned*)(ws + WS_BAR), MISC + 8);
#define GRID_BAR() xcd_barrier(bar)
    for (int rep = 0; rep < REP_P0; ++rep) {
    p0_prologue(a, lds);
    if (a.ws == nullptr) grid.sync();
    GRID_BAR();
    }
    { pg8::Gemm g{(const bf16*)(ws + WS_HB), (const bf16*)(ws + WS_WIN), T_, NPROJ, D_, D_}; pg8::StaticOrder S; S.init(T_, NPROJ, G, bx);
      pg8::EpiBf16<2> E{(bf16*)(ws + WS_PROJ), NPROJ, (float*)(ws + WS_DTRAW)};
      pg8::gemm_phase<pg8::EpiBf16<2>, pg8::StaticOrder, true, true>(lds, g, S, E); }
    GRID_BAR();
    for (int rep = 0; rep < REP_P23; ++rep) {
    { pg8::Gemm g{(const bf16*)(ws + WS_PROJ) + C_CQ, (const bf16*)(ws + WS_WUQ), T_, 768, 256, NPROJ}; pg8::StaticOrder S; S.init(T_, 768, G, bx);
      pg8::EpiBf16<0> E{(bf16*)(ws + WS_QRAW), 768, nullptr};
      pg8::gemm_phase<pg8::EpiBf16<0>, pg8::StaticOrder, true, true>(lds, g, S, E); }
    { pg8::Gemm g{(const bf16*)(ws + WS_PROJ) + C_CKV, (const bf16*)(ws + WS_WUKV), T_, 1024, 128, NPROJ}; pg8::StaticOrder S; S.init(T_, 1024, G, bx);
      pg8::EpiBf16<0> E{(bf16*)(ws + WS_KVRAW), 1024, nullptr};
      pg8::gemm_phase<pg8::EpiBf16<0>, pg8::StaticOrder, true, true>(lds, g, S, E); }
    prep_scan(a, lds);
    prep_conv(a, lds);
    GRID_BAR();
    p3_qkv(a, lds);
    ssd_chunk_states(a, lds);
    GRID_BAR();
    }
    for (int rep = 0; rep < REP_P4; ++rep) {
        float mq = 0.f, mk = 0.f;
        for (int i = 0; i < 96; ++i) { mq = fmaxf(mq, fabsf(a.q_norm_g[i])); mk = fmaxf(mk, fabsf(a.k_norm_g[i])); }
        const float mb = fminf(96.f * mq * mk * 0.10206207261596577f * LOG2E, 80.f);
        unsigned* s2cnt = (unsigned*)(ws + WS_BAR) + XCD_BAR_WORDS + 64;
        p0b_mlp_weights(a, lds);
        ssd_state_scan(a);
        split_arrive(s2cnt);
        for (int u = bx; u < 512; u += G) { const int qb = u & 7, h = (u >> 3) & 7, b = u >> 6; attn_item(lds, (const bf16*)(ws + WS_HB), (const bf16*)(ws + WS_K), (const bf16*)(ws + WS_VT), (bf16*)(ws + WS_MIXRAW), (float*)(ws + WS_SSQA), b, h, qb, mb); }
        split_wait(s2cnt, (unsigned)G * (unsigned)(rep + 1));
        for (int it = bx; it < 256; it += G) { const int qb = it & 7, hp = (it >> 3) & 3, b = it >> 5; ssd_item(lds, a, b, hp, qb); }
    GRID_BAR();
    }
    { pg8::Gemm g{(const bf16*)(ws + WS_MIXRAW), (const bf16*)(ws + WS_WOUT), T_, D_, D_, D_}; pg8::StaticOrder S; S.init(T_, D_, G, bx);
      LAS float* fac = (LAS float*)(lds + 128 * 1024);
      { const float* ssqa = (const float*)(ws + WS_SSQA); const float* ssqy = (const float*)(ws + WS_SSQY); pg8::Unit uu;
        if (threadIdx.x < 4) ((LAS int*)(fac + 4 * 768))[threadIdx.x] = -1;
        __syncthreads();
        for (int i = 0, nsl = 0, lastpm = -1; i < 16 && S.next(i, uu); ++i) { if (uu.pm == lastpm || nsl >= 4) continue; lastpm = uu.pm;
            if (threadIdx.x < 256) { const int row = uu.pm * 256 + threadIdx.x;
                const float sa = 1.0f / sqrtf(ssqa[row] * (1.0f / 512.0f) + EPS), s0 = 1.0f / sqrtf(ssqy[2 * row] * (1.0f / 256.0f) + EPS), s1 = 1.0f / sqrtf(ssqy[2 * row + 1] * (1.0f / 256.0f) + EPS);
                fac[nsl * 768 + threadIdx.x] = sa / s0; fac[nsl * 768 + 256 + threadIdx.x] = s0 / s1; fac[nsl * 768 + 512 + threadIdx.x] = s1; }
            if (threadIdx.x == 0) ((LAS int*)(fac + 4 * 768))[nsl] = uu.pm;
            ++nsl; }
        __syncthreads(); }
      pg8::EpiResidMix E{a.x, D_, (bf16*)(ws + WS_X1B), (float*)(ws + WS_SSQ), fac};
      pg8::gemm_phase<pg8::EpiResidMix, pg8::StaticOrder, true, true>(lds, g, S, E); }
    GRID_BAR();
    { pg8::Gemm g{(const bf16*)(ws + WS_X1B), (const bf16*)(ws + WS_WUP), T_, FF, D_, D_}; pg8::StaticOrder S; S.init(T_, FF, G, bx);
      pg8::EpiBf16<1> E{(bf16*)(ws + WS_U), FF, (float*)(ws + WS_SSQ)};
      pg8::gemm_phase<pg8::EpiBf16<1>, pg8::StaticOrder, true, true>(lds, g, S, E); }
    GRID_BAR();
    { pg8::Gemm g{(const bf16*)(ws + WS_U), (const bf16*)(ws + WS_WDN), T_, D_, FF, FF}; pg8::StaticOrder S; S.init(T_, D_, G, bx);
      pg8::EpiResid<false> E{nullptr, a.out, D_, (bf16*)(ws + WS_X1B), nullptr};
      pg8::gemm_phase<pg8::EpiResid<false>, pg8::StaticOrder, true, true>(lds, g, S, E); }
}

extern "C" void kernel_launch(void* const* d_in, const int* in_sizes, int n_in, void* d_out, int out_size, void* d_ws, size_t ws_size, hipStream_t stream) {
    static int grid = 0;
    if (grid == 0) {
        int dev = 0, cus = 0, per_cu = 0;
        hipGetDevice(&dev);
        hipDeviceGetAttribute(&cus, hipDeviceAttributeMultiprocessorCount, dev);
        if (hipFuncSetAttribute((const void*)fwd_megakernel, hipFuncAttributeMaxDynamicSharedMemorySize, LDS_BYTES) != hipSuccess) fprintf(stderr, "hipFuncSetAttribute failed\n");
        if (hipOccupancyMaxActiveBlocksPerMultiprocessor(&per_cu, (const void*)fwd_megakernel, NTHREADS, LDS_BYTES) != hipSuccess || per_cu < 1) { fprintf(stderr, "occupancy query: %d\n", per_cu); per_cu = 1; }
        (void)hipGetLastError();
        grid = cus * (per_cu > 1 ? 1 : per_cu);
        if (ws_size < 256 * MB) fprintf(stderr, "workspace too small: %zu\n", ws_size);
    }
    Args a{};
    a.x = (const float*)d_in[0]; a.pos = (const int*)d_in[1]; a.ln_mix_g = (const float*)d_in[2]; a.w_in = (const float*)d_in[3]; a.q_a_g = (const float*)d_in[4]; a.w_uq = (const float*)d_in[5];
    a.kv_a_g = (const float*)d_in[6]; a.w_ukv = (const float*)d_in[7]; a.q_norm_g = (const float*)d_in[8]; a.k_norm_g = (const float*)d_in[9]; a.attn_out_g = (const float*)d_in[10];
    a.conv_w = (const float*)d_in[11]; a.conv_b = (const float*)d_in[12]; a.a_log_f = (const float*)d_in[13]; a.a_log_b = (const float*)d_in[14]; a.dt_bias_f = (const float*)d_in[15];
    a.dt_bias_b = (const float*)d_in[16]; a.d_skip = (const float*)d_in[17]; a.ssm_norm_g = (const float*)d_in[18]; a.w_out = (const float*)d_in[19]; a.ln_mlp_g = (const float*)d_in[20];
    a.w_up = (const float*)d_in[21]; a.w_dn = (const float*)d_in[22]; a.out = (float*)d_out; a.ws = (unsigned char*)d_ws;
    (void)hipMemsetAsync((char*)d_ws + WS_BAR, 0, (XCD_BAR_WORDS + 128) * 4, stream);
    void* args[] = {&a};
    hipError_t e = hipLaunchCooperativeKernel((const void*)fwd_megakernel, dim3(grid), dim3(NTHREADS), args, LDS_BYTES, stream);
    if (e != hipSuccess) fprintf(stderr, "cooperative launch failed: %s (grid %d)\n", hipGetErrorString(e), grid);
}
```
